# Optimizing an MI355X kernel written in HIP

```python
import math
import jax, jax.numpy as jnp
from jax import lax
import numpy as np


D_MODEL = 2048
BATCH = 4
SEQ = 2048
DEPTH = 2
DEC_BATCH = 128
DEC_SEQ = 4
PAST_LEN = 16384
PAGE_SIZE = 128

D_MIX = D_MODEL
D_LRU = D_MIX // 2
D_SGU = D_MIX - D_LRU
LRU_HEADS = 8
LRU_HEAD_DIM = D_LRU // LRU_HEADS
CONV_WIDTH = 4
LRU_C = 8.0
CHUNK = 128
SGU_HEADS = 8
SGU_HEAD_DIM = D_SGU // SGU_HEADS
MEM_LEN = 256
XA_HEADS = 4
XA_HEAD_DIM = D_MODEL // XA_HEADS
D_FF = ((8 * D_MODEL // 3 + 127) // 128) * 128
HALF = 0.5
EPS = 1e-6

kernel_name = "hymba_rglru_sgu_macaron_step"


def rms_norm(x, g):
    xf = x.astype(jnp.float32)
    y = xf * lax.rsqrt(jnp.mean(xf * xf, axis=-1, keepdims=True) + EPS)
    return (y * g.astype(jnp.float32)).astype(x.dtype)


def layer_norm(x, g, b):
    xf = x.astype(jnp.float32)
    mu = jnp.mean(xf, axis=-1, keepdims=True)
    xc = xf - mu
    y = xc * lax.rsqrt(jnp.mean(xc * xc, axis=-1, keepdims=True) + EPS)
    return (y * g.astype(jnp.float32) + b.astype(jnp.float32)).astype(x.dtype)


def swiglu(x, w_in, w_down):
    gate, up = jnp.split(x @ w_in, 2, axis=-1)
    return (jax.nn.silu(gate) * up) @ w_down


def causal_conv(x, buf, w, b):
    xx = jnp.concatenate([buf.astype(x.dtype), x], axis=1)
    t = x.shape[1]
    y = b + sum(xx[:, k:k + t] * w[k] for k in range(CONV_WIDTH))
    return y, xx[:, -(CONV_WIDTH - 1):]


def _lru_combine(left, right):
    a_l, b_l = left
    a_r, b_r = right
    return a_l * a_r, a_r * b_l + b_r


def rg_lru(x, h0, w_a, b_a, w_i, b_i, lam):
    n, t, _ = x.shape
    xh = x.reshape(n, t, LRU_HEADS, LRU_HEAD_DIM)
    r = jax.nn.sigmoid(jnp.einsum('nthd,hde->nthe', xh, w_a) + b_a).reshape(n, t, D_LRU)
    i = jax.nn.sigmoid(jnp.einsum('nthd,hde->nthe', xh, w_i) + b_i).reshape(n, t, D_LRU)
    log_a = (-LRU_C * jax.nn.softplus(-lam.astype(jnp.float32))) * r.astype(jnp.float32)
    a = jnp.exp(log_a)
    b = jnp.sqrt(-jnp.expm1(2.0 * log_a)) * (i * x).astype(jnp.float32)
    b = b.at[:, 0].add(a[:, 0] * h0.astype(jnp.float32))
    _, h = lax.associative_scan(_lru_combine, (a, b), axis=1)
    return h, h[:, -1]


def spatial_gating(u, v, w_s, b_s):
    n, t, _ = u.shape
    rows = min(t, CHUNK)
    nc = t // rows
    mask = jnp.tril(jnp.ones((rows, rows), dtype=bool))
    ws = jnp.where(mask, w_s[:, :rows, :rows], 0).astype(v.dtype)
    vh = v.reshape(n, nc, rows, SGU_HEADS, SGU_HEAD_DIM)
    bias = b_s[:, :rows].T[:, :, None].astype(v.dtype)
    s = jnp.einsum('gts,ncsgd->nctgd', ws, vh) + bias
    return u * s.reshape(n, t, D_SGU)


def memory_kv(mem, g_mem, w_kv):
    n, m, _ = mem.shape
    k, v = jnp.split(rms_norm(mem, g_mem) @ w_kv, 2, axis=-1)
    return (k.reshape(n, m, XA_HEADS, XA_HEAD_DIM), v.reshape(n, m, XA_HEADS, XA_HEAD_DIM))


def cross_attention(h, k, v, w_q, w_o):
    n, t, _ = h.shape
    q = (h @ w_q).reshape(n, t, XA_HEADS, XA_HEAD_DIM)
    s = jnp.einsum('nthd,nmhd->nhtm', q, k.astype(q.dtype)).astype(jnp.float32) * (XA_HEAD_DIM ** -0.5)
    p = jax.nn.softmax(s, axis=-1).astype(q.dtype)
    o = jnp.einsum('nhtm,nmhd->nthd', p, v.astype(q.dtype)).reshape(n, t, D_MODEL)
    return o @ w_o


def decoder_layer(x, conv_buf, h0, mem_k, mem_v, p):
    h = rms_norm(x, p['ffn1_norm'][0])
    x = x + HALF * rms_norm(swiglu(h, p['ffn1_w_in'], p['ffn1_w_down']), p['ffn1_norm'][1])
    h = rms_norm(x, p['mix_norm'][0])
    z = h @ p['w_in']
    x_lru, g_lru, u_sgu, v_sgu = jnp.split(z, [D_LRU, 2 * D_LRU, 2 * D_LRU + D_SGU], axis=-1)
    xc, conv_new = causal_conv(x_lru, conv_buf, p['conv_w'], p['conv_b'])
    h_seq, h_last = rg_lru(xc, h0, p['lru_w_a'], p['lru_b_a'], p['lru_w_i'], p['lru_b_i'], p['lru_lambda'])
    y_lru = h_seq.astype(x.dtype) * jax.nn.gelu(g_lru)
    u = jax.nn.gelu(u_sgu)
    v = layer_norm(jax.nn.gelu(v_sgu), p['sgu_ln'][0], p['sgu_ln'][1])
    y_sgu = spatial_gating(u, v, p['sgu_w'], p['sgu_b'])
    mix = jnp.concatenate([y_lru, y_sgu], axis=-1) @ p['w_out']
    x = x + rms_norm(mix, p['mix_norm'][1])
    h = rms_norm(x, p['xa_norm'][0])
    x = x + rms_norm(cross_attention(h, mem_k, mem_v, p['xa_w_q'], p['xa_w_o']), p['xa_norm'][1])
    h = rms_norm(x, p['ffn2_norm'][0])
    x = x + HALF * rms_norm(swiglu(h, p['ffn2_w_in'], p['ffn2_w_down']), p['ffn2_norm'][1])
    return x, conv_new, h_last, v


def setup_inputs(seed: int = 0) -> dict:
    key = jax.random.key(seed)
    ks = iter(jax.random.split(key, 40))

    def nrm(shape, scale):
        return jax.random.normal(next(ks), shape, jnp.float32) * scale

    def gain(shape):
        return 1.0 + nrm(shape, 0.05)

    a8 = jax.random.uniform(next(ks), (DEPTH, D_LRU), jnp.float32, minval=0.9, maxval=0.999)
    a_base = a8 ** (1.0 / LRU_C)
    lru_lambda = jnp.log(a_base) - jnp.log1p(-a_base)
    return {
        'x_prompt': nrm((BATCH, SEQ, D_MODEL), 1.0),
        'x_sample': nrm((DEC_BATCH, DEC_SEQ, D_MODEL), 1.0),
        'mem_prompt': nrm((BATCH, MEM_LEN, D_MODEL), 1.0),
        'cache_mem_k': nrm((DEPTH, DEC_BATCH, MEM_LEN, XA_HEADS, XA_HEAD_DIM), 1.0),
        'cache_mem_v': nrm((DEPTH, DEC_BATCH, MEM_LEN, XA_HEADS, XA_HEAD_DIM), 1.0),
        'state_conv': nrm((DEPTH, DEC_BATCH, CONV_WIDTH - 1, D_LRU), 1.0),
        'state_lru_h': nrm((DEPTH, DEC_BATCH, D_LRU), 0.5),
        'ffn1_norm': gain((DEPTH, 2, D_MODEL)),
        'ffn1_w_in': nrm((DEPTH, D_MODEL, 2 * D_FF), D_MODEL ** -0.5),
        'ffn1_w_down': nrm((DEPTH, D_FF, D_MODEL), D_FF ** -0.5),
        'mix_norm': gain((DEPTH, 2, D_MODEL)),
        'w_in': nrm((DEPTH, D_MODEL, 2 * D_LRU + 2 * D_SGU), D_MODEL ** -0.5),
        'conv_w': nrm((DEPTH, CONV_WIDTH, D_LRU), CONV_WIDTH ** -0.5),
        'conv_b': nrm((DEPTH, D_LRU), 0.01),
        'lru_w_a': nrm((DEPTH, LRU_HEADS, LRU_HEAD_DIM, LRU_HEAD_DIM), LRU_HEAD_DIM ** -0.5),
        'lru_b_a': nrm((DEPTH, LRU_HEADS, LRU_HEAD_DIM), 0.01),
        'lru_w_i': nrm((DEPTH, LRU_HEADS, LRU_HEAD_DIM, LRU_HEAD_DIM), LRU_HEAD_DIM ** -0.5),
        'lru_b_i': nrm((DEPTH, LRU_HEADS, LRU_HEAD_DIM), 0.01),
        'lru_lambda': lru_lambda,
        'sgu_ln': jnp.stack([gain((DEPTH, D_SGU)), nrm((DEPTH, D_SGU), 0.01)], axis=1),
        'sgu_w': nrm((DEPTH, SGU_HEADS, CHUNK, CHUNK), CHUNK ** -0.5),
        'sgu_b': gain((DEPTH, SGU_HEADS, CHUNK)),
        'w_out': nrm((DEPTH, D_MIX, D_MODEL), D_MIX ** -0.5),
        'xa_norm': gain((DEPTH, 3, D_MODEL)),
        'xa_w_q': nrm((DEPTH, D_MODEL, D_MODEL), D_MODEL ** -0.5),
        'xa_w_kv': nrm((DEPTH, D_MODEL, 2 * D_MODEL), D_MODEL ** -0.5),
        'xa_w_o': nrm((DEPTH, D_MODEL, D_MODEL), D_MODEL ** -0.5),
        'ffn2_norm': gain((DEPTH, 2, D_MODEL)),
        'ffn2_w_in': nrm((DEPTH, D_MODEL, 2 * D_FF), D_MODEL ** -0.5),
        'ffn2_w_down': nrm((DEPTH, D_FF, D_MODEL), D_FF ** -0.5),
    }


def reference(x_prompt, x_sample, mem_prompt, cache_mem_k, cache_mem_v, state_conv, state_lru_h,
              ffn1_norm, ffn1_w_in, ffn1_w_down, mix_norm, w_in, conv_w, conv_b,
              lru_w_a, lru_b_a, lru_w_i, lru_b_i, lru_lambda, sgu_ln, sgu_w, sgu_b, w_out,
              xa_norm, xa_w_q, xa_w_kv, xa_w_o, ffn2_norm, ffn2_w_in, ffn2_w_down):
    yp, ys = x_prompt, x_sample
    n_p = x_prompt.shape[0]
    mk_p, mv_p, cv_p, h_p, cv_s, h_s, v_s = [], [], [], [], [], [], []
    for l in range(DEPTH):
        p = {
            'ffn1_norm': ffn1_norm[l], 'ffn1_w_in': ffn1_w_in[l], 'ffn1_w_down': ffn1_w_down[l],
            'mix_norm': mix_norm[l], 'w_in': w_in[l], 'conv_w': conv_w[l], 'conv_b': conv_b[l],
            'lru_w_a': lru_w_a[l], 'lru_b_a': lru_b_a[l], 'lru_w_i': lru_w_i[l], 'lru_b_i': lru_b_i[l],
            'lru_lambda': lru_lambda[l], 'sgu_ln': sgu_ln[l], 'sgu_w': sgu_w[l], 'sgu_b': sgu_b[l],
            'w_out': w_out[l], 'xa_norm': xa_norm[l], 'xa_w_q': xa_w_q[l], 'xa_w_o': xa_w_o[l],
            'ffn2_norm': ffn2_norm[l], 'ffn2_w_in': ffn2_w_in[l], 'ffn2_w_down': ffn2_w_down[l],
        }
        k_mem, v_mem = memory_kv(mem_prompt, xa_norm[l, 2], xa_w_kv[l])
        yp, conv_new, h_last, _ = decoder_layer(
            yp, jnp.zeros((n_p, CONV_WIDTH - 1, D_LRU), yp.dtype),
            jnp.zeros((n_p, D_LRU), jnp.float32), k_mem, v_mem, p)
        mk_p.append(k_mem)
        mv_p.append(v_mem)
        cv_p.append(conv_new)
        h_p.append(h_last)
        ys, conv_new_s, h_last_s, v_rows = decoder_layer(
            ys, state_conv[l], state_lru_h[l], cache_mem_k[l], cache_mem_v[l], p)
        cv_s.append(conv_new_s)
        h_s.append(h_last_s)
        v_s.append(v_rows)
    return (yp, ys, jnp.stack(mk_p), jnp.stack(mv_p), jnp.stack(cv_p), jnp.stack(h_p),
            jnp.stack(cv_s), jnp.stack(h_s), jnp.stack(v_s))
```

```cpp
#include <hip/hip_runtime.h>
#include <cstdio>
#include <cstdint>

#ifndef KOUT_T
#define KOUT_T true
#endif
#ifndef KOUT_Q
#define KOUT_Q true
#endif
#ifndef KOUT_M
#define KOUT_M true
#endif
#ifndef PH_ONLY
#define PH_ONLY (-1)
#endif
#define PHT(j) (PH_ONLY < 0 || PH_ONLY == (j))
#ifndef MK_PER_PHASE
#define MK_PER_PHASE 0
#endif

namespace pg8 {
#define PG8_LAS __attribute__((address_space(3)))
typedef unsigned short bf16_t;
typedef short bf16x8 __attribute__((ext_vector_type(8)));
typedef float f32x4 __attribute__((ext_vector_type(4)));
typedef float f32x2 __attribute__((ext_vector_type(2)));
typedef unsigned u32x4 __attribute__((ext_vector_type(4)));
typedef unsigned u32x2 __attribute__((ext_vector_type(2)));
constexpr int KIND_SLAB = 8;
constexpr int BM = 256, BK = 64, HALF = 128, HTB = HALF * BK * 2  , STAGE_BYTES = 8 * HTB, NXCD = 8, WGM = 4;

__host__ __device__ __forceinline__ int lds_byte(int r, int c) { const int st = (r >> 4) * 2 + (c >> 5), rr = r & 15, cc = c & 31, ob = rr * 64 + cc * 2; return st * 1024 + (ob ^ (((ob >> 9) & 1) << 5)); }
__host__ __device__ __forceinline__ void stage_rc(int b, int& R, int& C) { const int st = b / 1024, sb = b % 1024, swz = sb ^ (((sb >> 9) & 1) << 5); R = (st >> 1) * 16 + swz / 64; C = (st & 1) * 32 + (swz % 64) / 2; }
__host__ __device__ __forceinline__ int perm32(int rho) { const int n = rho >> 4, i = rho & 15; return 8 * (i >> 2) + 4 * n + (i & 3); }

#define PG8_GAS __attribute__((address_space(1)))
__device__ __forceinline__ int lane_id() { unsigned z = 0u; asm volatile("" : "+v"(z)); return (int)__builtin_amdgcn_mbcnt_hi(~0u, __builtin_amdgcn_mbcnt_lo(~0u, z)); }
__device__ __forceinline__ float shx(float v, int m) {
    const int iv = __float_as_int(v); int r;
    switch (m) {
        case 1:  r = __builtin_amdgcn_ds_swizzle(iv, 0x041F); break;
        case 2:  r = __builtin_amdgcn_ds_swizzle(iv, 0x081F); break;
        case 4:  r = __builtin_amdgcn_ds_swizzle(iv, 0x101F); break;
        case 8:  r = __builtin_amdgcn_ds_swizzle(iv, 0x201F); break;
        case 16: r = __builtin_amdgcn_ds_swizzle(iv, 0x401F); break;
        default: r = __builtin_amdgcn_ds_bpermute((lane_id() ^ 32) << 2, iv); break;
    }
    return __int_as_float(r);
}
__device__ __forceinline__ float rs_of(const __attribute__((address_space(1))) float* SSQ, int row) {
    typedef float f4 __attribute__((ext_vector_type(4)));
    const f4 a = *(const __attribute__((address_space(1))) f4*)(SSQ + (size_t)row * 8), b = *(const __attribute__((address_space(1))) f4*)(SSQ + (size_t)row * 8 + 4);
    return __builtin_amdgcn_rsqf((((a[0] + a[1]) + (a[2] + a[3])) + ((b[0] + b[1]) + (b[2] + b[3]))) * (1.0f / 2048.0f) + 1e-6f);
}
__device__ __forceinline__ void rs8_of(const __attribute__((address_space(1))) float* SSQ, int row0, float (&r)[2][4]) {
    typedef float f4 __attribute__((ext_vector_type(4)));
    f4 a[2][4], b[2][4];
#pragma unroll
    for (int ai = 0; ai < 2; ++ai)
#pragma unroll
        for (int m = 0; m < 4; ++m) { const __attribute__((address_space(1))) f4* p = (const __attribute__((address_space(1))) f4*)(SSQ + (size_t)(row0 + ai * 128 + m * 16) * 8); a[ai][m] = p[0]; b[ai][m] = p[1]; }
#pragma unroll
    for (int ai = 0; ai < 2; ++ai)
#pragma unroll
        for (int m = 0; m < 4; ++m) { r[ai][m] = __builtin_amdgcn_rsqf((((a[ai][m][0] + a[ai][m][1]) + (a[ai][m][2] + a[ai][m][3])) + ((b[ai][m][0] + b[ai][m][1]) + (b[ai][m][2] + b[ai][m][3]))) * (1.0f / 2048.0f) + 1e-6f);
            asm volatile("" : "+v"(r[ai][m])); }
}
struct GUnit { const PG8_GAS char* a; const PG8_GAS char* b; int sd; int orow, ocol, kind, nt, srow; };

__device__ __forceinline__ void tile_of(int wgid, int nM, int nN, int& pm, int& pn) {
    const int nwg = nM * nN;
    { const int q = nwg / NXCD, r = nwg % NXCD, xcd = wgid % NXCD, off = wgid / NXCD; wgid = (xcd < r ? xcd * (q + 1) : r * (q + 1) + (xcd - r) * q) + off; }
    const int nig = WGM * nN, gid = wgid / nig, fm = gid * WGM, gsz = (nM - fm) < WGM ? (nM - fm) : WGM;
    pm = fm + ((wgid % nig) % gsz); pn = (wgid % nig) / gsz;
}

__device__ __forceinline__ unsigned cvt_pk_bf16(float lo, float hi) { unsigned r; asm volatile("v_cvt_pk_bf16_f32 %0, %1, %2" : "=v"(r) : "v"(lo), "v"(hi)); return r; }
__device__ __forceinline__ float fast_sigmoid(float x) { return __builtin_amdgcn_rcpf(1.0f + __builtin_amdgcn_exp2f(-1.44269504089f * x)); }
__device__ __forceinline__ float silu_f(float x) { return x * fast_sigmoid(x); }
typedef float f32x2 __attribute__((ext_vector_type(2)));
__device__ __forceinline__ unsigned swiglu2_pk(float ga, float gb, float ua, float ub) {
    const f32x2 g = {ga, gb}, u = {ua, ub};
    const f32x2 t = g * -1.44269504089f;
    f32x2 e = {__builtin_amdgcn_exp2f(t.x), __builtin_amdgcn_exp2f(t.y)};
    e = e + 1.0f;
    const f32x2 r = {__builtin_amdgcn_rcpf(e.x), __builtin_amdgcn_rcpf(e.y)};
    const f32x2 h = (g * u) * r;
    return cvt_pk_bf16(h.x, h.y);
}
__device__ __forceinline__ float gelu_f(float x) { const float t = x * (1.0f + 0.044715f * x * x); return x * __builtin_amdgcn_rcpf(1.0f + __builtin_amdgcn_exp2f(-2.30220819814f * t)); }

template <class Epi, class Sched, bool ALIGN_EPI, bool SP2, bool STRIP = false, bool KOUT = true>
__device__ __forceinline__ void gemm_phase(PG8_LAS unsigned char* lds, const int wave_s, const int lda_, const int ldb_, const Sched& S, const Epi& E) {
    int lda = lda_, ldb = ldb_;
    asm volatile("" : "+s"(lda), "+s"(ldb));
    int tid = wave_s * 64 + lane_id(); asm volatile("" : "+v"(tid));
    const int wid = __builtin_amdgcn_readfirstlane(tid >> 6), lane = tid & 63, wr = wid >> 2, wc = wid & 3, fr = lane & 15, fq = lane >> 4;
    unsigned voffA, voffB;
    { int R, C; stage_rc(tid * 16, R, C); const int Rb = Epi::PERM ? ((R & ~31) + perm32(R & 31)) : R;
        voffA = (unsigned)(R * lda + C) * 2u; voffB = (unsigned)(Rb * ldb + C) * 2u; }
    const size_t r64A = (size_t)64 * lda * 2, r64B = (size_t)64 * ldb * 2;
    const size_t kstep = (size_t)(BK * 2);
    const size_t hstepA = (size_t)HALF * lda * 2, hstepB = (size_t)HALF * ldb * 2;
    const unsigned ldsw = (unsigned)wid * 1024u;
    const int aoff = lds_byte(wr * 64 + fr, fq * 8), boff = lds_byte(wc * 32 + fr, fq * 8);
    const bool s_act = STRIP && lane < 16;
    unsigned vs_s = 0; int so_s = 0;
    if constexpr (STRIP) { const int c_ = wid * 16 + (lane & 15), r_ = c_ >> 3, g_ = (c_ & 7) ^ ((r_ >> 1) & 7); vs_s = (unsigned)(r_ * lda) * 2u + (unsigned)(g_ * 16);
        so_s = fr * 128 + ((fq ^ ((fr >> 1) & 7)) * 16); }
    PG8_LAS unsigned char* ldsB = lds + 65536 + boff; asm volatile("" : "+v"(ldsB));
    PG8_LAS unsigned char* ldsS0 = lds + STAGE_BYTES + so_s; PG8_LAS unsigned char* ldsS1 = lds + STAGE_BYTES + (so_s ^ 64);
    unsigned sm0_s = (unsigned)__builtin_amdgcn_readfirstlane((int)(unsigned)(size_t)(lds + STAGE_BYTES + wid * 256));
    if constexpr (STRIP) { asm volatile("" : "+v"(ldsS0), "+v"(ldsS1), "+s"(sm0_s)); }
    static_assert(!STRIP || SP2, "the strip rides on the SP2 loop");
#define PG8_SA(b, h) (((b) * 2 + (h)) * HTB)
#define PG8_SB(b, h) ((4 + (b) * 2 + (h)) * HTB)
#define PG8_STAGE(bufoff, gbase, voff) do { asm volatile("" : "+v"(voff)); const unsigned vo_ = (voff);     \
        _Pragma("unroll") for (int _i = 0; _i < 2; ++_i) { const PG8_GAS char* gb_ = (gbase) + (size_t)_i * r64_##voff; asm volatile("" : "+s"(gb_));     \
        __builtin_amdgcn_global_load_lds((const PG8_GAS unsigned*)(gb_ + vo_), (PG8_LAS unsigned*)(lds + (bufoff) + ldsw + _i * 8192), 16, 0, 0); } } while (0)
#define r64_voffA r64A
#define r64_voffB r64B
#define PG8_LDA(dst, b, h) do { _Pragma("unroll") for (int m = 0; m < 4; ++m) _Pragma("unroll") for (int k = 0; k < 2; ++k) dst[m][k] = *(const PG8_LAS bf16x8*)(lds + PG8_SA(b, h) + aoff + m * 2048 + k * 1024); } while (0)
#define PG8_LDB(dst, b, h) do { _Pragma("unroll") for (int n = 0; n < 2; ++n) _Pragma("unroll") for (int k = 0; k < 2; ++k) dst[n][k] = *(const PG8_LAS bf16x8*)(ldsB + (PG8_SB(b, h) - 65536) + n * 2048 + k * 1024); } while (0)
#define PG8_MMA(ai, bj, At, Bt) do { __builtin_amdgcn_s_setprio(1); \
        if constexpr (KOUT) { _Pragma("unroll") for (int k = 0; k < 2; ++k) _Pragma("unroll") for (int m = 0; m < 4; ++m) _Pragma("unroll") for (int n_ = 0; n_ < 2; ++n_) { const int n = ((m ^ k) & 1) ? 1 - n_ : n_;     \
            acc[ai][bj][m][n] = __builtin_amdgcn_mfma_f32_16x16x32_bf16(Bt[n][k], At[m][k], acc[ai][bj][m][n], 0, 0, 0); } } \
        else { _Pragma("unroll") for (int m = 0; m < 4; ++m) _Pragma("unroll") for (int n = 0; n < 2; ++n) _Pragma("unroll") for (int k = 0; k < 2; ++k) \
            acc[ai][bj][m][n] = __builtin_amdgcn_mfma_f32_16x16x32_bf16(Bt[n][k], At[m][k], acc[ai][bj][m][n], 0, 0, 0); } \
        __builtin_amdgcn_s_setprio(0); } while (0)
#define PG8_MMA2(ai, At, B0, B1) do { if constexpr (KOUT) { __builtin_amdgcn_s_setprio(1); \
        _Pragma("unroll") for (int k = 0; k < 2; ++k) _Pragma("unroll") for (int m = 0; m < 4; ++m) _Pragma("unroll") for (int c_ = 0; c_ < 4; ++c_) { const int c = ((m ^ k) & 1) ? 3 - c_ : c_; \
            if (c < 2) acc[ai][0][m][c] = __builtin_amdgcn_mfma_f32_16x16x32_bf16(B0[c][k], At[m][k], acc[ai][0][m][c], 0, 0, 0); \
            else acc[ai][1][m][c - 2] = __builtin_amdgcn_mfma_f32_16x16x32_bf16(B1[c - 2][k], At[m][k], acc[ai][1][m][c - 2], 0, 0, 0); } \
        __builtin_amdgcn_s_setprio(0); } else { PG8_MMA(ai, 0, At, B0); PG8_MMA(ai, 1, At, B1); } } while (0)
#define PG8_SS(b) (STAGE_BYTES + (b) * 2048)
#define PG8_STAGE_S(b, gbase) do { if constexpr (STRIP) { \
        if (s_act) {        \
            const PG8_GAS char* gs_ = (gbase); asm volatile("" : "+v"(vs_s), "+s"(gs_)); const unsigned vs_ = vs_s; \
            __builtin_amdgcn_global_load_lds((const PG8_GAS unsigned*)(gs_ + vs_), (PG8_LAS unsigned*)(size_t)(sm0_s + (b) * 2048), 16, 0, 0); } } } while (0)
#define PG8_LDS_S(b) do { if constexpr (STRIP) { \
        As[0] = *(const PG8_LAS bf16x8*)(ldsS0 + (b) * 2048); As[1] = *(const PG8_LAS bf16x8*)(ldsS1 + (b) * 2048); } } while (0)
#define PG8_MMA_S() do { if constexpr (STRIP) { if (wr) { _Pragma("unroll") for (int k = 0; k < 2; ++k) { acc_s[0] = __builtin_amdgcn_mfma_f32_16x16x32_bf16(B0[1][k], As[k], acc_s[0], 0, 0, 0); acc_s[1] = __builtin_amdgcn_mfma_f32_16x16x32_bf16(B1[1][k], As[k], acc_s[1], 0, 0, 0); } } \
        else { _Pragma("unroll") for (int k = 0; k < 2; ++k) { acc_s[0] = __builtin_amdgcn_mfma_f32_16x16x32_bf16(B0[0][k], As[k], acc_s[0], 0, 0, 0); acc_s[1] = __builtin_amdgcn_mfma_f32_16x16x32_bf16(B1[0][k], As[k], acc_s[1], 0, 0, 0); } } } } while (0)
#define PG8_WAIT_V(n) asm volatile("s_waitcnt vmcnt(" #n ")" ::: "memory")
#define PG8_WAIT_VS(n, ns) do { if constexpr (STRIP) PG8_WAIT_V(ns); else PG8_WAIT_V(n); } while (0)
#define PG8_WAIT_L(n) asm volatile("s_waitcnt lgkmcnt(" #n ")" ::: "memory")
#define PG8_BAR __builtin_amdgcn_s_barrier()
#define PG8_SCHED __builtin_amdgcn_sched_barrier(0)
    GUnit cur, nxt; int ui = 0;
    if (!S.next(0, cur)) return;
    f32x4 acc[2][2][4][2];
#pragma unroll
    for (int a = 0; a < 2; ++a)
#pragma unroll
        for (int b = 0; b < 2; ++b)
#pragma unroll
            for (int m = 0; m < 4; ++m)
#pragma unroll
                for (int n = 0; n < 2; ++n) acc[a][b][m][n] = (f32x4){0.f, 0.f, 0.f, 0.f};
    bf16x8 At[4][2], B0[2][2], B1[2][2];
    bf16x8 As[2]; f32x4 acc_s[2]; acc_s[0] = (f32x4){0.f, 0.f, 0.f, 0.f}; acc_s[1] = (f32x4){0.f, 0.f, 0.f, 0.f};
    const PG8_GAS char* cA = cur.a; const PG8_GAS char* cB = cur.b; int cSd = cur.sd;
    if constexpr (SP2) {
        PG8_STAGE(PG8_SB(0, 0), cB, voffB); PG8_STAGE(PG8_SB(0, 1), cB + hstepB, voffB); PG8_STAGE(PG8_SA(0, 0), cA, voffA); PG8_STAGE_S(0, cA + cSd); PG8_STAGE(PG8_SA(0, 1), cA + hstepA, voffA);
        if (wr == 1) PG8_BAR;
        PG8_WAIT_V(2); PG8_BAR;
        PG8_STAGE(PG8_SB(1, 0), cB + kstep, voffB); PG8_STAGE(PG8_SA(1, 0), cA + kstep, voffA); PG8_STAGE(PG8_SB(1, 1), cB + hstepB + kstep, voffB); PG8_STAGE_S(1, cA + kstep + cSd);
        PG8_WAIT_VS(6, 7); PG8_BAR;
    } else {
        PG8_STAGE(PG8_SB(0, 0), cB, voffB); PG8_STAGE(PG8_SA(0, 0), cA, voffA); PG8_STAGE(PG8_SB(0, 1), cB + hstepB, voffB); PG8_STAGE(PG8_SA(0, 1), cA + hstepA, voffA);
        if (wr == 1) PG8_BAR;
        PG8_WAIT_V(4); PG8_BAR;
        PG8_STAGE(PG8_SB(1, 0), cB + kstep, voffB); PG8_STAGE(PG8_SA(1, 0), cA + kstep, voffA); PG8_STAGE(PG8_SB(1, 1), cB + hstepB + kstep, voffB);
        PG8_WAIT_V(6); PG8_BAR;
    }
    for (;;) {
        const bool has_next = S.next(ui + 1, nxt);
        int nt = cur.nt; asm volatile("" : "+s"(nt));
        const PG8_GAS char* nA = has_next ? nxt.a : cA; const PG8_GAS char* nB = has_next ? nxt.b : cB; const int nSd = has_next ? nxt.sd : cSd;
        for (int t = 0; t < nt; t += 2) {
            const bool last = (t == nt - 2);
            const PG8_GAS char* a1 = cA + (size_t)(t + 1) * kstep;
            const PG8_GAS char* a2 = last ? nA : cA + (size_t)(t + 2) * kstep; const PG8_GAS char* b2 = last ? nB : cB + (size_t)(t + 2) * kstep;
            const PG8_GAS char* a3 = a2 + kstep; const PG8_GAS char* b3 = b2 + kstep;
            const int sd2 = last ? nSd : cSd;
            if constexpr (SP2) {
            PG8_LDB(B0, 0, 0); PG8_LDB(B1, 0, 1); PG8_SCHED; PG8_LDA(At, 0, 0); PG8_LDS_S(0); PG8_STAGE(PG8_SA(1, 1), a1 + hstepA, voffA);
            PG8_WAIT_VS(8, 9); PG8_WAIT_L(0); PG8_BAR; PG8_MMA2(0, At, B0, B1); PG8_MMA_S(); PG8_BAR; PG8_SCHED;
            PG8_LDA(At, 0, 1); PG8_STAGE(PG8_SB(0, 0), b2, voffB); PG8_STAGE(PG8_SB(0, 1), b2 + hstepB, voffB); PG8_STAGE(PG8_SA(0, 0), a2, voffA); PG8_STAGE_S(0, a2 + sd2);
            PG8_WAIT_VS(8, 9); PG8_WAIT_L(0); PG8_BAR; PG8_MMA2(1, At, B0, B1); PG8_BAR; PG8_SCHED;
            PG8_LDB(B0, 1, 0); PG8_LDB(B1, 1, 1); PG8_SCHED; PG8_LDA(At, 1, 0); PG8_LDS_S(1); PG8_STAGE(PG8_SA(0, 1), a2 + hstepA, voffA);
            PG8_WAIT_VS(8, 9); PG8_WAIT_L(0); PG8_BAR; PG8_MMA2(0, At, B0, B1); PG8_MMA_S(); PG8_BAR; PG8_SCHED;
            PG8_LDA(At, 1, 1); PG8_STAGE(PG8_SB(1, 0), b3, voffB); PG8_STAGE(PG8_SB(1, 1), b3 + hstepB, voffB); PG8_STAGE(PG8_SA(1, 0), a3, voffA); PG8_STAGE_S(1, a3 + sd2);
            PG8_WAIT_VS(8, 9); PG8_WAIT_L(0); PG8_BAR; PG8_MMA2(1, At, B0, B1); PG8_BAR; PG8_SCHED;
            } else {
            PG8_LDB(B0, 0, 0); PG8_SCHED; PG8_LDA(At, 0, 0); PG8_STAGE(PG8_SA(1, 1), a1 + hstepA, voffA);
            PG8_WAIT_L(8); PG8_BAR; PG8_WAIT_L(0); PG8_MMA(0, 0, At, B0); PG8_BAR; PG8_SCHED;
            PG8_LDB(B1, 0, 1); PG8_STAGE(PG8_SB(0, 0), b2, voffB);
            PG8_BAR; PG8_WAIT_L(0); PG8_MMA(0, 1, At, B1); PG8_BAR;
            PG8_LDA(At, 0, 1); PG8_STAGE(PG8_SA(0, 0), a2, voffA);
            PG8_BAR; PG8_WAIT_L(0); PG8_MMA(1, 0, At, B0); PG8_BAR; PG8_SCHED;
            PG8_STAGE(PG8_SB(0, 1), b2 + hstepB, voffB);
            PG8_WAIT_V(6); PG8_BAR; PG8_MMA(1, 1, At, B1); PG8_BAR;
            PG8_LDB(B0, 1, 0); PG8_SCHED; PG8_LDA(At, 1, 0); PG8_STAGE(PG8_SA(0, 1), a2 + hstepA, voffA);
            PG8_WAIT_L(8); PG8_BAR; PG8_WAIT_L(0); PG8_MMA(0, 0, At, B0); PG8_BAR; PG8_SCHED;
            PG8_LDB(B1, 1, 1); PG8_STAGE(PG8_SB(1, 0), b3, voffB);
            PG8_BAR; PG8_WAIT_L(0); PG8_MMA(0, 1, At, B1); PG8_BAR;
            PG8_LDA(At, 1, 1); PG8_STAGE(PG8_SA(1, 0), a3, voffA);
            PG8_BAR; PG8_WAIT_L(0); PG8_MMA(1, 0, At, B0); PG8_BAR; PG8_SCHED;
            PG8_STAGE(PG8_SB(1, 1), b3 + hstepB, voffB);
            PG8_WAIT_V(6); PG8_BAR; PG8_MMA(1, 1, At, B1); PG8_BAR;
            }
        }
        if constexpr (ALIGN_EPI) { if (wr == 0) PG8_BAR; }
        if constexpr (!Epi::AFTER_DRAIN) { const int le_ = lane_id(), fre_ = le_ & 15, fqe_ = le_ >> 4;
            E(acc, cur, wr, wc, fre_, fqe_); if constexpr (STRIP) { E.strip(acc_s, cur, wr, wc, fre_, fqe_); acc_s[0] = (f32x4){0.f, 0.f, 0.f, 0.f}; acc_s[1] = (f32x4){0.f, 0.f, 0.f, 0.f}; } }
        if (!has_next) break;
#pragma unroll
        for (int a = 0; a < 2; ++a)
#pragma unroll
            for (int b = 0; b < 2; ++b)
#pragma unroll
                for (int m = 0; m < 4; ++m)
#pragma unroll
                    for (int n = 0; n < 2; ++n) acc[a][b][m][n] = (f32x4){0.f, 0.f, 0.f, 0.f};
        cur = nxt; cA = nA; cB = nB; cSd = nSd; ++ui;
        if constexpr (ALIGN_EPI) { if (wr == 1) PG8_BAR; }
    }
    PG8_WAIT_V(0);
    if constexpr (!ALIGN_EPI) { if (wr == 0) PG8_BAR; }
    PG8_BAR;
    if constexpr (Epi::AFTER_DRAIN) {
        int t2 = wave_s * 64 + lane_id(); asm volatile("" : "+v"(t2));
        const int wid2 = __builtin_amdgcn_readfirstlane(t2 >> 6), lane2 = t2 & 63;
        if constexpr (STRIP) E.fused(acc, acc_s, cur, wid2 >> 2, wid2 & 3, lane2 & 15, lane2 >> 4, lds, wid2, lane2); else E.fused(acc, cur, wid2 >> 2, wid2 & 3, lane2 & 15, lane2 >> 4, lds, wid2, lane2); }
#undef PG8_SA
#undef PG8_SB
#undef PG8_STAGE
#undef r64_voffA
#undef r64_voffB
#undef PG8_LDA
#undef PG8_LDB
#undef PG8_MMA
#undef PG8_MMA2
#undef PG8_WAIT_V
#undef PG8_WAIT_VS
#undef PG8_SS
#undef PG8_STAGE_S
#undef PG8_LDS_S
#undef PG8_MMA_S
#undef PG8_WAIT_L
#undef PG8_BAR
#undef PG8_SCHED
}

typedef f32x4 acc_t[2][2][4][2];

struct EpiD {
    static constexpr bool PERM = true, AFTER_DRAIN = false;
    PG8_GAS bf16_t* D; PG8_GAS float* SL;
    __device__ __forceinline__ void strip(const f32x4 (&as)[2], const GUnit& u, int wr, int wc, int fr, int fq) const {
        PG8_GAS bf16_t* rowp = D + (size_t)(u.srow + fr) * 2048 + u.ocol + wc * 32 + 8 * fq + 4 * wr;
#pragma unroll
        for (int bj = 0; bj < 2; ++bj) { u32x2 w; w.x = cvt_pk_bf16(as[bj][0], as[bj][1]); w.y = cvt_pk_bf16(as[bj][2], as[bj][3]); *(PG8_GAS u32x2*)(rowp + bj * HALF) = w; }
    }
    __device__ __forceinline__ void operator()(const acc_t& acc, const GUnit& u, int wr, int wc, int fr, int fq) const {
        const int row0 = u.orow + wr * 64 + fr, col0 = u.ocol + wc * 32 + 8 * fq;
        if (u.kind == KIND_SLAB) {
#pragma unroll
            for (int ai = 0; ai < 2; ++ai)
#pragma unroll
                for (int m = 0; m < 4; ++m) { PG8_GAS float* rowp = SL + (size_t)(row0 + ai * HALF + m * 16) * 2048 + col0;
#pragma unroll
                    for (int bj = 0; bj < 2; ++bj) { *(PG8_GAS f32x4*)(rowp + bj * HALF) = acc[ai][bj][m][0]; *(PG8_GAS f32x4*)(rowp + bj * HALF + 4) = acc[ai][bj][m][1]; } }
        } else {
#pragma unroll
            for (int ai = 0; ai < 2; ++ai)
#pragma unroll
                for (int m = 0; m < 4; ++m) { PG8_GAS bf16_t* rowp = D + (size_t)(row0 + ai * HALF + m * 16) * 2048 + col0;
#pragma unroll
                    for (int bj = 0; bj < 2; ++bj) { const f32x4 v0 = acc[ai][bj][m][0], v1 = acc[ai][bj][m][1];
                        u32x4 w; w.x = cvt_pk_bf16(v0[0], v0[1]); w.y = cvt_pk_bf16(v0[2], v0[3]); w.z = cvt_pk_bf16(v1[0], v1[1]); w.w = cvt_pk_bf16(v1[2], v1[3]);
                        *(PG8_GAS u32x4*)(rowp + bj * HALF) = w; } }
        }
    }
};
struct EpiFfnIn {
    static constexpr bool PERM = true, AFTER_DRAIN = false;
    PG8_GAS bf16_t* O; int ldo; PG8_GAS float* KF; PG8_GAS bf16_t* KB; PG8_GAS float* VF; PG8_GAS bf16_t* VT; const PG8_GAS float* RS;
    __device__ __forceinline__ void operator()(const acc_t& acc, const GUnit& u, int wr, int wc, int fr, int fq) const {
        const int row0 = u.orow + wr * 64 + fr, col0 = u.ocol + wc * 32 + 8 * fq;
        if (u.kind == 0) {
            float rsv[2][4]; rs8_of(RS, row0, rsv);
#pragma unroll
            for (int ai = 0; ai < 2; ++ai)
#pragma unroll
                for (int m = 0; m < 4; ++m) { PG8_GAS bf16_t* rowp = O + (size_t)(row0 + ai * HALF + m * 16) * ldo + col0; const float rs = rsv[ai][m];
                    const f32x4 g0 = acc[ai][0][m][0] * rs, g1 = acc[ai][0][m][1] * rs, u0 = acc[ai][1][m][0] * rs, u1 = acc[ai][1][m][1] * rs;
                    u32x4 w; w.x = swiglu2_pk(g0[0], g0[1], u0[0], u0[1]); w.y = swiglu2_pk(g0[2], g0[3], u0[2], u0[3]);
                    w.z = swiglu2_pk(g1[0], g1[1], u1[0], u1[1]); w.w = swiglu2_pk(g1[2], g1[3], u1[2], u1[3]);
                    *(PG8_GAS u32x4*)rowp = w; }
        } else if (u.kind == 1) {
#pragma unroll
            for (int ai = 0; ai < 2; ++ai)
#pragma unroll
                for (int m = 0; m < 4; ++m) { const size_t ro = (size_t)(row0 + ai * HALF + m * 16) * 2048 + col0;
#pragma unroll
                    for (int bj = 0; bj < 2; ++bj) { const f32x4 v0 = acc[ai][bj][m][0], v1 = acc[ai][bj][m][1];
                        *(PG8_GAS f32x4*)(KF + ro + bj * HALF) = v0; *(PG8_GAS f32x4*)(KF + ro + bj * HALF + 4) = v1;
                        u32x4 w; w.x = cvt_pk_bf16(v0[0], v0[1]); w.y = cvt_pk_bf16(v0[2], v0[3]); w.z = cvt_pk_bf16(v1[0], v1[1]); w.w = cvt_pk_bf16(v1[2], v1[3]);
                        *(PG8_GAS u32x4*)(KB + ro + bj * HALF) = w; } }
        } else {
#pragma unroll
            for (int ai = 0; ai < 2; ++ai)
#pragma unroll
                for (int m = 0; m < 4; ++m) { const int row = row0 + ai * HALF + m * 16;
#pragma unroll
                    for (int bj = 0; bj < 2; ++bj) { const f32x4 v0 = acc[ai][bj][m][0], v1 = acc[ai][bj][m][1];
                        u32x4 w; w.x = cvt_pk_bf16(v0[0], v0[1]); w.y = cvt_pk_bf16(v0[2], v0[3]); w.z = cvt_pk_bf16(v1[0], v1[1]); w.w = cvt_pk_bf16(v1[2], v1[3]);
                        *(PG8_GAS u32x4*)(VT + (size_t)row * 1024 + col0 + bj * HALF) = w;
                        PG8_GAS float* vp = VF + (size_t)(col0 + bj * HALF) * 2048 + row;
#pragma unroll
                        for (int j = 0; j < 4; ++j) { vp[(size_t)j * 2048] = v0[j]; vp[(size_t)(4 + j) * 2048] = v1[j]; } } }
        }
    }
};
struct EpiMixIn {
    static constexpr bool PERM = true, AFTER_DRAIN = false;
    PG8_GAS float* XL; PG8_GAS bf16_t* GL; PG8_GAS bf16_t* UG; PG8_GAS float* VG; PG8_GAS float* VST; PG8_GAS float* SL;
    const PG8_GAS float* RS;
    __device__ __forceinline__ void strip(const f32x4 (&as)[2], const GUnit& u, int wr, int wc, int fr, int fq) const {
        const int row = u.srow + fr, col = u.ocol + wc * 32 + 8 * fq + 4 * wr; const float rs = rs_of(RS, row);
#pragma unroll
        for (int bj = 0; bj < 2; ++bj) { const f32x4 v = as[bj] * rs;
            if (u.kind == 0) *(PG8_GAS f32x4*)(XL + (size_t)row * 1024 + col + bj * HALF) = v;
            else if (u.kind == 3) *(PG8_GAS f32x4*)(VG + (size_t)row * 1024 + col + bj * HALF) = (f32x4){gelu_f(v[0]), gelu_f(v[1]), gelu_f(v[2]), gelu_f(v[3])};
            else { u32x2 w; w.x = cvt_pk_bf16(gelu_f(v[0]), gelu_f(v[1])); w.y = cvt_pk_bf16(gelu_f(v[2]), gelu_f(v[3])); *(PG8_GAS u32x2*)(((u.kind == 1) ? GL : UG) + (size_t)row * 1024 + col + bj * HALF) = w; } }
    }
    __device__ __forceinline__ void operator()(const acc_t& acc, const GUnit& u, int wr, int wc, int fr, int fq) const {
        const int row0 = u.orow + wr * 64 + fr, col0 = u.ocol + wc * 32 + 8 * fq;
        float rsv[2][4]; rs8_of(RS, row0, rsv);
        if (u.kind == 0 || u.kind == KIND_SLAB) {
            PG8_GAS float* Fb = (u.kind == 0) ? XL : SL; const int ldf = (u.kind == 0) ? 1024 : 4096;
#pragma unroll
            for (int ai = 0; ai < 2; ++ai)
#pragma unroll
                for (int m = 0; m < 4; ++m) { PG8_GAS float* rowp = Fb + (size_t)(row0 + ai * HALF + m * 16) * ldf + col0; const float rs = rsv[ai][m];
#pragma unroll
                    for (int bj = 0; bj < 2; ++bj) { *(PG8_GAS f32x4*)(rowp + bj * HALF) = acc[ai][bj][m][0] * rs; *(PG8_GAS f32x4*)(rowp + bj * HALF + 4) = acc[ai][bj][m][1] * rs; } }
        } else if (u.kind == 3) {
#pragma unroll
            for (int ai = 0; ai < 2; ++ai)
#pragma unroll
                for (int m = 0; m < 4; ++m) { const int row = row0 + ai * HALF + m * 16; PG8_GAS float* rowp = VG + (size_t)row * 1024 + col0; float s = 0.f, q = 0.f; const float rs = rsv[ai][m];
#pragma unroll
                    for (int bj = 0; bj < 2; ++bj) { f32x4 v0 = acc[ai][bj][m][0] * rs, v1 = acc[ai][bj][m][1] * rs;
#pragma unroll
                        for (int j = 0; j < 4; ++j) { v0[j] = gelu_f(v0[j]); v1[j] = gelu_f(v1[j]); s += v0[j] + v1[j]; q += v0[j] * v0[j] + v1[j] * v1[j]; }
                        *(PG8_GAS f32x4*)(rowp + bj * HALF) = v0; *(PG8_GAS f32x4*)(rowp + bj * HALF + 4) = v1; }
                    s += pg8::shx(s, 16); s += pg8::shx(s, 32); q += pg8::shx(q, 16); q += pg8::shx(q, 32);
                    if (fq == 0) *(PG8_GAS f32x2*)(VST + ((size_t)row * 16 + (u.ocol >> 8) * 4 + wc) * 2) = (f32x2){s, q}; }
        } else {
            PG8_GAS bf16_t* O = (u.kind == 1) ? GL : UG;
#pragma unroll
            for (int ai = 0; ai < 2; ++ai)
#pragma unroll
                for (int m = 0; m < 4; ++m) { PG8_GAS bf16_t* rowp = O + (size_t)(row0 + ai * HALF + m * 16) * 1024 + col0; const float rs = rsv[ai][m];
#pragma unroll
                    for (int bj = 0; bj < 2; ++bj) { const f32x4 v0 = acc[ai][bj][m][0] * rs, v1 = acc[ai][bj][m][1] * rs;
                        u32x4 w; w.x = cvt_pk_bf16(gelu_f(v0[0]), gelu_f(v0[1])); w.y = cvt_pk_bf16(gelu_f(v0[2]), gelu_f(v0[3])); w.z = cvt_pk_bf16(gelu_f(v1[0]), gelu_f(v1[1])); w.w = cvt_pk_bf16(gelu_f(v1[2]), gelu_f(v1[3]));
                        *(PG8_GAS u32x4*)(rowp + bj * HALF) = w; } }
        }
    }
};
struct EpiQ {
    static constexpr bool PERM = true, AFTER_DRAIN = false;
    PG8_GAS bf16_t* Q; PG8_GAS float* SL; const PG8_GAS float* RS; int mp;
    __device__ __forceinline__ void strip(const f32x4 (&as)[2], const GUnit& u, int wr, int wc, int fr, int fq) const {
        const int row = u.srow + fr; const float rs = rs_of(RS, row); PG8_GAS bf16_t* rowp = Q + (size_t)row * 2048 + u.ocol + wc * 32 + 8 * fq + 4 * wr;
#pragma unroll
        for (int bj = 0; bj < 2; ++bj) { u32x2 w; w.x = cvt_pk_bf16(as[bj][0] * rs, as[bj][1] * rs); w.y = cvt_pk_bf16(as[bj][2] * rs, as[bj][3] * rs); *(PG8_GAS u32x2*)(rowp + bj * HALF) = w; }
    }
    __device__ __forceinline__ void operator()(const acc_t& acc, const GUnit& u, int wr, int wc, int fr, int fq) const {
        const int row0 = u.orow + wr * 64 + fr, col0 = u.ocol + wc * 32 + 8 * fq;
        const int rsrow0 = (u.kind == KIND_SLAB) ? mp + ((u.orow & 511) + wr * 64 + fr) : row0;
        float rsv[2][4]; rs8_of(RS, rsrow0, rsv);
        if (u.kind == KIND_SLAB) {
#pragma unroll
            for (int ai = 0; ai < 2; ++ai)
#pragma unroll
                for (int m = 0; m < 4; ++m) { PG8_GAS float* rowp = SL + (size_t)(row0 + ai * HALF + m * 16) * 2048 + col0; const float rs = rsv[ai][m];
#pragma unroll
                    for (int bj = 0; bj < 2; ++bj) { *(PG8_GAS f32x4*)(rowp + bj * HALF) = acc[ai][bj][m][0] * rs; *(PG8_GAS f32x4*)(rowp + bj * HALF + 4) = acc[ai][bj][m][1] * rs; } }
        } else {
#pragma unroll
            for (int ai = 0; ai < 2; ++ai)
#pragma unroll
                for (int m = 0; m < 4; ++m) { PG8_GAS bf16_t* rowp = Q + (size_t)(row0 + ai * HALF + m * 16) * 2048 + col0; const float rs = rsv[ai][m];
#pragma unroll
                    for (int bj = 0; bj < 2; ++bj) { const f32x4 v0 = acc[ai][bj][m][0] * rs, v1 = acc[ai][bj][m][1] * rs;
                        u32x4 w; w.x = cvt_pk_bf16(v0[0], v0[1]); w.y = cvt_pk_bf16(v0[2], v0[3]); w.z = cvt_pk_bf16(v1[0], v1[1]); w.w = cvt_pk_bf16(v1[2], v1[3]);
                        *(PG8_GAS u32x4*)(rowp + bj * HALF) = w; } }
        }
    }
};
struct EpiBf16 {
    static constexpr bool PERM = true, AFTER_DRAIN = false;
    PG8_GAS bf16_t* O; int ldo;
    __device__ __forceinline__ void operator()(const acc_t& acc, const GUnit& u, int wr, int wc, int fr, int fq) const {
        const int row0 = u.orow + wr * 64 + fr, col0 = u.ocol + wc * 32 + 8 * fq;
#pragma unroll
        for (int ai = 0; ai < 2; ++ai)
#pragma unroll
            for (int m = 0; m < 4; ++m) { PG8_GAS bf16_t* rowp = O + (size_t)(row0 + ai * HALF + m * 16) * ldo + col0;
#pragma unroll
                for (int bj = 0; bj < 2; ++bj) { const f32x4 v0 = acc[ai][bj][m][0], v1 = acc[ai][bj][m][1];
                    u32x4 w; w.x = cvt_pk_bf16(v0[0], v0[1]); w.y = cvt_pk_bf16(v0[2], v0[3]); w.z = cvt_pk_bf16(v1[0], v1[1]); w.w = cvt_pk_bf16(v1[2], v1[3]);
                    *(PG8_GAS u32x4*)(rowp + bj * HALF) = w; } }
    }
};
struct EpiSoftmax {
    static constexpr bool PERM = true, AFTER_DRAIN = true;
    PG8_GAS bf16_t* P; int ldp; float scale_log2e;
    __device__ __forceinline__ void fused(acc_t& acc, const GUnit& u, int wr, int wc, int fr, int fq, PG8_LAS unsigned char* lds, int wid, int lane) const {
        PG8_LAS float* RM = (PG8_LAS float*)lds;
        PG8_LAS float* RS = (PG8_LAS float*)(lds + 4096);
#pragma unroll
        for (int ai = 0; ai < 2; ++ai)
#pragma unroll
            for (int m = 0; m < 4; ++m) { float mx = -3.0e38f;
#pragma unroll
                for (int bj = 0; bj < 2; ++bj)
#pragma unroll
                    for (int n = 0; n < 2; ++n) { const f32x4 x = acc[ai][bj][m][n]; mx = fmaxf(mx, fmaxf(fmaxf(x[0], x[1]), fmaxf(x[2], x[3]))); }
                mx = fmaxf(mx, pg8::shx(mx, 16)); mx = fmaxf(mx, pg8::shx(mx, 32));
                if (fq == 0) RM[(ai * HALF + wr * 64 + m * 16 + fr) * 4 + wc] = mx; }
        asm volatile("s_waitcnt lgkmcnt(0)" ::: "memory"); __builtin_amdgcn_s_barrier(); asm volatile("" ::: "memory");
#pragma unroll
        for (int ai = 0; ai < 2; ++ai)
#pragma unroll
            for (int m = 0; m < 4; ++m) { const int r = ai * HALF + wr * 64 + m * 16 + fr; const f32x4 mm = *(const PG8_LAS f32x4*)(RM + r * 4);
                const float mx = fmaxf(fmaxf(mm[0], mm[1]), fmaxf(mm[2], mm[3])) * scale_log2e; float s = 0.f;
#pragma unroll
                for (int bj = 0; bj < 2; ++bj)
#pragma unroll
                    for (int n = 0; n < 2; ++n) { f32x4 x = acc[ai][bj][m][n];
#pragma unroll
                        for (int j = 0; j < 4; ++j) { x[j] = __builtin_amdgcn_exp2f(x[j] * scale_log2e - mx); s += x[j]; }
                        acc[ai][bj][m][n] = x; }
                s += pg8::shx(s, 16); s += pg8::shx(s, 32);
                if (fq == 0) RS[r * 4 + wc] = s; }
        asm volatile("s_waitcnt lgkmcnt(0)" ::: "memory"); __builtin_amdgcn_s_barrier(); asm volatile("" ::: "memory");
        const int row0 = u.orow + wr * 64 + fr, col0 = u.ocol + wc * 32 + 8 * fq;
#pragma unroll
        for (int ai = 0; ai < 2; ++ai)
#pragma unroll
            for (int m = 0; m < 4; ++m) { const int r = ai * HALF + wr * 64 + m * 16 + fr; const f32x4 ss = *(const PG8_LAS f32x4*)(RS + r * 4);
                const float inv = 1.0f / ((ss[0] + ss[1]) + (ss[2] + ss[3])); PG8_GAS bf16_t* rowp = P + (size_t)(row0 + ai * HALF + m * 16) * ldp + col0;
#pragma unroll
                for (int bj = 0; bj < 2; ++bj) { const f32x4 v0 = acc[ai][bj][m][0] * inv, v1 = acc[ai][bj][m][1] * inv;
                    u32x4 w; w.x = cvt_pk_bf16(v0[0], v0[1]); w.y = cvt_pk_bf16(v0[2], v0[3]); w.z = cvt_pk_bf16(v1[0], v1[1]); w.w = cvt_pk_bf16(v1[2], v1[3]);
                    *(PG8_GAS u32x4*)(rowp + bj * HALF) = w; } }
        asm volatile("s_waitcnt lgkmcnt(0)" ::: "memory"); __builtin_amdgcn_s_barrier(); asm volatile("" ::: "memory");
    }
};
struct EpiT {
    static constexpr bool PERM = true, AFTER_DRAIN = true;
    const PG8_GAS float* XF0; const PG8_GAS float* XF1;
    PG8_GAS bf16_t* XH; PG8_GAS float* OUT; const PG8_GAS float* G1; float c;
    PG8_GAS float* XB; PG8_GAS unsigned* CNT; PG8_GAS float* SSQ; int mode;
    __device__ __forceinline__ void fused(acc_t& acc, f32x4 (&as)[2], const GUnit& u, int wr, int wc, int fr, int fq, PG8_LAS unsigned char* lds, int wid, int lane) const {
        PG8_LAS float* PW = (PG8_LAS float*)(lds + STAGE_BYTES);
        PG8_LAS float* PS = (PG8_LAS float*)(lds + STAGE_BYTES + 4096);
        PG8_LAS float* SR = (PG8_LAS float*)(lds + STAGE_BYTES + 4608);
        const int pm = u.orow >> 8, pn = u.ocol >> 8, tid = wid * 64 + lane;
        unsigned ldsx_ = (unsigned)(size_t)(lds + wid * 1024); asm volatile("" : "+s"(ldsx_));
        PG8_LAS unsigned char* ldsx = (PG8_LAS unsigned char*)(size_t)ldsx_;
        if (mode != 1) {
#pragma unroll
            for (int ai = 0; ai < 2; ++ai)
#pragma unroll
                for (int m = 0; m < 4; ++m)
#pragma unroll
                    for (int bj = 0; bj < 2; ++bj)
                        __builtin_amdgcn_global_load_lds((const PG8_GAS unsigned*)(XH + (size_t)(u.orow + ai * HALF + wr * 64 + m * 16 + fr) * 2048 + u.ocol + bj * HALF + wc * 32 + 8 * fq),
                                                         (PG8_LAS unsigned*)(ldsx + ((ai * 4 + m) * 2 + bj) * 8192), 16, 0, 0);
        }
#pragma unroll
        for (int ai = 0; ai < 2; ++ai)
#pragma unroll
            for (int m = 0; m < 4; ++m) { float q = 0.f;
#pragma unroll
                for (int bj = 0; bj < 2; ++bj)
#pragma unroll
                    for (int n = 0; n < 2; ++n) { const f32x4 v = acc[ai][bj][m][n]; q += (v[0] * v[0] + v[1] * v[1]) + (v[2] * v[2] + v[3] * v[3]); }
                q += pg8::shx(q, 16); q += pg8::shx(q, 32);
                if (fq == 0) PW[(ai * HALF + wr * 64 + m * 16 + fr) * 4 + wc] = q; }
        { float q = 0.f;
#pragma unroll
            for (int bj = 0; bj < 2; ++bj) { const f32x4 v = as[bj]; q += (v[0] * v[0] + v[1] * v[1]) + (v[2] * v[2] + v[3] * v[3]); }
            q += pg8::shx(q, 16); q += pg8::shx(q, 32);
            if (fq == 0) PS[fr * 8 + wid] = q; }
        asm volatile("s_waitcnt lgkmcnt(0)" ::: "memory"); __builtin_amdgcn_s_barrier(); asm volatile("" ::: "memory");
        PG8_GAS float* xb = XB + ((size_t)pm * 272) * 8;
        if (tid < 272) { float p;
            if (tid < 256) { const f32x4 t = *(const PG8_LAS f32x4*)(PW + tid * 4); p = (t[0] + t[1]) + (t[2] + t[3]); }
            else { const f32x4 t0 = *(const PG8_LAS f32x4*)(PS + (tid - 256) * 8), t1 = *(const PG8_LAS f32x4*)(PS + (tid - 256) * 8 + 4); p = ((t0[0] + t0[1]) + (t0[2] + t0[3])) + ((t1[0] + t1[1]) + (t1[2] + t1[3])); }
            __hip_atomic_store((PG8_GAS unsigned*)(xb + (size_t)tid * 8 + pn), __float_as_uint(p), __ATOMIC_RELAXED, __HIP_MEMORY_SCOPE_AGENT); }
        asm volatile("s_waitcnt vmcnt(0)" ::: "memory"); __builtin_amdgcn_s_barrier(); asm volatile("" ::: "memory");
        if (tid == 0) (void)__hip_atomic_fetch_add(CNT + 16 * pm, 1u, __ATOMIC_RELAXED, __HIP_MEMORY_SCOPE_AGENT);
        if (wid == 0) { unsigned spins = 0;
            while ((unsigned)__builtin_amdgcn_readfirstlane((int)__hip_atomic_load(CNT + 16 * pm, __ATOMIC_RELAXED, __HIP_MEMORY_SCOPE_AGENT)) < 8u) { __builtin_amdgcn_s_sleep(1); if (++spins > (1u << 20)) break; }
            __builtin_amdgcn_fence(__ATOMIC_ACQUIRE, "agent"); asm volatile("s_waitcnt vmcnt(0)" ::: "memory"); }
        __builtin_amdgcn_s_barrier(); asm volatile("" ::: "memory");
        if (tid < 272) { float sum = 0.f;
#pragma unroll
            for (int k = 0; k < 8; ++k) sum += __uint_as_float(__hip_atomic_load((PG8_GAS unsigned*)(xb + (size_t)tid * 8 + k), __ATOMIC_RELAXED, __HIP_MEMORY_SCOPE_AGENT));
            SR[tid] = c * __builtin_amdgcn_rsqf(sum * (1.0f / 2048.0f) + 1e-6f); }
        asm volatile("s_waitcnt lgkmcnt(0)" ::: "memory"); __builtin_amdgcn_s_barrier(); asm volatile("" ::: "memory");
        asm volatile("s_waitcnt vmcnt(0)" ::: "memory");
#pragma unroll
        for (int ai = 0; ai < 2; ++ai)
#pragma unroll
            for (int m = 0; m < 4; ++m) { const int rl = ai * HALF + wr * 64 + m * 16 + fr, grow = u.orow + rl; const float sc = SR[rl]; float q = 0.f;
#pragma unroll
                for (int bj = 0; bj < 2; ++bj) { const int col = u.ocol + bj * HALF + wc * 32 + 8 * fq; const size_t o = (size_t)grow * 2048 + col;
                    f32x4 x0, x1;
                    if (mode == 1) { x0 = *(const PG8_GAS f32x4*)(XF0 + o); x1 = *(const PG8_GAS f32x4*)(XF0 + o + 4); }
                    else { const u32x4 w = *(const PG8_LAS u32x4*)(lds + ((ai * 4 + m) * 2 + bj) * 8192 + wid * 1024 + lane * 16);
                        x0 = (f32x4){__uint_as_float(w.x << 16), __uint_as_float(w.x & 0xffff0000u), __uint_as_float(w.y << 16), __uint_as_float(w.y & 0xffff0000u)};
                        x1 = (f32x4){__uint_as_float(w.z << 16), __uint_as_float(w.z & 0xffff0000u), __uint_as_float(w.w << 16), __uint_as_float(w.w & 0xffff0000u)}; }
                    const f32x4 g0 = *(const PG8_GAS f32x4*)(G1 + col), g1v = *(const PG8_GAS f32x4*)(G1 + col + 4);
                    x0 = x0 + acc[ai][bj][m][0] * sc * g0; x1 = x1 + acc[ai][bj][m][1] * sc * g1v;
                    if (mode == 2) { *(PG8_GAS f32x4*)(OUT + o) = x0; *(PG8_GAS f32x4*)(OUT + o + 4) = x1; }
                    else { u32x4 w; w.x = cvt_pk_bf16(x0[0], x0[1]); w.y = cvt_pk_bf16(x0[2], x0[3]); w.z = cvt_pk_bf16(x1[0], x1[1]); w.w = cvt_pk_bf16(x1[2], x1[3]); *(PG8_GAS u32x4*)(XH + o) = w;
                        q += ((x0[0] * x0[0] + x0[1] * x0[1]) + (x0[2] * x0[2] + x0[3] * x0[3])) + ((x1[0] * x1[0] + x1[1] * x1[1]) + (x1[2] * x1[2] + x1[3] * x1[3])); } }
                q += pg8::shx(q, 16); q += pg8::shx(q, 32);
                if (fq == 0) PW[rl * 4 + wc] = q; }
        { const int grow = u.srow + fr; const float sc = SR[256 + fr]; float q = 0.f;
#pragma unroll
            for (int bj = 0; bj < 2; ++bj) { const int col = u.ocol + bj * HALF + wc * 32 + 8 * fq + 4 * wr; const size_t o = (size_t)grow * 2048 + col;
                f32x4 x0;
                if (mode == 1) x0 = *(const PG8_GAS f32x4*)(XF1 + (size_t)(grow - 8192) * 2048 + col);
                else { const u32x2 w = *(const PG8_GAS u32x2*)(XH + o); x0 = (f32x4){__uint_as_float(w.x << 16), __uint_as_float(w.x & 0xffff0000u), __uint_as_float(w.y << 16), __uint_as_float(w.y & 0xffff0000u)}; }
                const f32x4 g0 = *(const PG8_GAS f32x4*)(G1 + col);
                x0 = x0 + as[bj] * sc * g0;
                if (mode == 2) *(PG8_GAS f32x4*)(OUT + o) = x0;
                else { u32x2 w; w.x = cvt_pk_bf16(x0[0], x0[1]); w.y = cvt_pk_bf16(x0[2], x0[3]); *(PG8_GAS u32x2*)(XH + o) = w; q += (x0[0] * x0[0] + x0[1] * x0[1]) + (x0[2] * x0[2] + x0[3] * x0[3]); } }
            q += pg8::shx(q, 16); q += pg8::shx(q, 32);
            if (fq == 0) PS[fr * 8 + wid] = q; }
        asm volatile("s_waitcnt lgkmcnt(0)" ::: "memory"); __builtin_amdgcn_s_barrier(); asm volatile("" ::: "memory");
        if (mode != 2 && tid < 272) { float p; int grow;
            if (tid < 256) { const f32x4 t = *(const PG8_LAS f32x4*)(PW + tid * 4); p = (t[0] + t[1]) + (t[2] + t[3]); grow = u.orow + tid; }
            else { const f32x4 t0 = *(const PG8_LAS f32x4*)(PS + (tid - 256) * 8), t1 = *(const PG8_LAS f32x4*)(PS + (tid - 256) * 8 + 4); p = ((t0[0] + t0[1]) + (t0[2] + t0[3])) + ((t1[0] + t1[1]) + (t1[2] + t1[3])); grow = u.srow + (tid - 256); }
            SSQ[(size_t)grow * 8 + pn] = p; }
        asm volatile("s_waitcnt lgkmcnt(0)" ::: "memory"); __builtin_amdgcn_s_barrier(); asm volatile("" ::: "memory");
    }
};
}

constexpr int NWAVES = 8;
constexpr int DM = 2048, NB = 4, SEQ = 2048, DEPTH = 2, DECB = 128, DECS = 4;
constexpr int DLRU = 1024, DSGU = 1024, CHUNK = 128, MEML = 256, XAH = 4, XAD = 512, DFF = 5504;
constexpr int MP = NB * SEQ;
constexpr int MS = DECB * DECS;
constexpr int MT = MP + MS;
constexpr int MMEM = NB * MEML;
constexpr float EPS = 1e-6f;

constexpr size_t al256(size_t x) { return (x + 255) & ~(size_t)255; }
constexpr size_t WS_CTL = 0, CTL_ZERO_BYTES = 1u << 20;
constexpr size_t WL_FIN1 = 0;
constexpr size_t WL_FDN1 = WL_FIN1 + (size_t)2 * DFF * DM * 2;
constexpr size_t WL_WIN  = WL_FDN1 + (size_t)DM * DFF * 2;
constexpr size_t WL_WOUT = WL_WIN + (size_t)4096 * DM * 2;
constexpr size_t WL_WQ   = WL_WOUT + (size_t)DM * DM * 2;
constexpr size_t WL_WKV  = WL_WQ + (size_t)DM * DM * 2;
constexpr size_t WL_WO   = WL_WKV + (size_t)4096 * DM * 2;
constexpr size_t WL_FIN2 = WL_WO + (size_t)DM * DM * 2;
constexpr size_t WL_FDN2 = WL_FIN2 + (size_t)2 * DFF * DM * 2;
constexpr size_t WL_LRA  = WL_FDN2 + (size_t)DM * DFF * 2;
constexpr size_t WL_LRI  = WL_LRA + (size_t)8 * 128 * 128 * 2;
constexpr size_t WL_SGW  = WL_LRI + (size_t)8 * 128 * 128 * 2;
constexpr size_t WL_SIZE = al256(WL_SGW + (size_t)8 * 128 * 128 * 2);
constexpr size_t WS_W = CTL_ZERO_BYTES;
constexpr size_t WS_XB   = WS_W + DEPTH * WL_SIZE;
constexpr size_t WS_HB   = WS_XB + (size_t)MT * DM * 4;
constexpr size_t WS_ACT  = WS_HB + (size_t)MT * DM * 2;
constexpr size_t WS_DB   = WS_ACT + (size_t)MT * DFF * 2;
constexpr size_t WS_XL   = WS_DB + (size_t)MT * DM * 4;
constexpr size_t WS_GL   = WS_XL + (size_t)MT * 1024 * 4;
constexpr size_t WS_UG   = WS_GL + (size_t)MT * 1024 * 2;
constexpr size_t WS_VG   = WS_UG + (size_t)MT * 1024 * 2;
constexpr size_t WS_VST  = WS_VG + (size_t)MT * 1024 * 4;
constexpr size_t WS_HLOC = WS_VST + (size_t)MT * 32 * 4;
constexpr size_t WS_PC   = WS_HLOC + (size_t)MP * 1024 * 4;
constexpr size_t WS_CSUM = WS_PC + (size_t)MP * 1024 * 4;
constexpr size_t WS_YMIX = WS_CSUM + (size_t)4 * 16 * 1024 * 2 * 4;
constexpr size_t WS_QB   = WS_YMIX + (size_t)MT * DM * 2;
constexpr size_t WS_PB   = WS_QB + (size_t)MT * DM * 2;
constexpr size_t WS_OB   = WS_PB + (size_t)MP * 1024 * 2;
constexpr size_t WS_MEMN = WS_OB + (size_t)MT * DM * 2;
constexpr size_t WS_KB   = WS_MEMN + (size_t)DEPTH * MMEM * DM * 2;
constexpr size_t WS_VT   = WS_KB + (size_t)MMEM * DM * 2;
constexpr size_t WS_SLAB = WS_VT + (size_t)DM * MMEM * 2;
constexpr int NSPLIT = 8;
constexpr size_t WS_RS   = WS_SLAB + (size_t)NSPLIT * MS * 4096 * 4;
constexpr size_t WS_TXB  = al256(WS_RS + (size_t)MT * 8 * 4);
constexpr size_t WS_CS   = al256(WS_TXB + (size_t)8 * 32 * 272 * 8 * 4);
constexpr size_t WS_END  = WS_CS + (size_t)DEPTH * 512 * 128 * 8;

constexpr size_t OUT_YP = 0, OUT_YS = OUT_YP + (size_t)MP * DM, OUT_MK = OUT_YS + (size_t)MS * DM, OUT_MV = OUT_MK + (size_t)DEPTH * MMEM * DM,
                 OUT_CVP = OUT_MV + (size_t)DEPTH * MMEM * DM, OUT_HP = OUT_CVP + (size_t)DEPTH * NB * 3 * DLRU, OUT_CVS = OUT_HP + (size_t)DEPTH * NB * DLRU,
                 OUT_HS = OUT_CVS + (size_t)DEPTH * DECB * 3 * DLRU, OUT_VS = OUT_HS + (size_t)DEPTH * DECB * DLRU, OUT_END = OUT_VS + (size_t)DEPTH * DECB * DECS * DSGU;

constexpr int CW_BAR = 4096;
constexpr int CW_LRUF = 16384;
constexpr int CW_TC = 49152;
constexpr int CW_XF = 57344;
constexpr int CW_QC = 40960;

constexpr int RING_BYTES = 131072;
constexpr int LDS_BYTES = 155648;
constexpr int MISC_OFF = LDS_BYTES - 256;
constexpr int TAB_OFF = LDS_BYTES - 768;

#define GAS __attribute__((address_space(1)))
#define LAS __attribute__((address_space(3)))
typedef unsigned short bf16;
typedef unsigned v4u __attribute__((ext_vector_type(4)));
typedef unsigned v2u __attribute__((ext_vector_type(2)));
typedef float f32x4 __attribute__((ext_vector_type(4)));
typedef float f32x2 __attribute__((ext_vector_type(2)));
typedef short bf16x8 __attribute__((ext_vector_type(8)));
typedef GAS unsigned gu32;
#define RLX_AGENT __ATOMIC_RELAXED, __HIP_MEMORY_SCOPE_AGENT
#define LDS_WAIT() asm volatile("s_waitcnt lgkmcnt(0)" ::: "memory")
#define VM_WAIT() asm volatile("s_waitcnt vmcnt(0)" ::: "memory")
__device__ __forceinline__ unsigned f2bf(float f) { unsigned u = __builtin_bit_cast(unsigned, f); return (u + 0x7fffu + ((u >> 16) & 1u)) >> 16; }
__device__ __forceinline__ unsigned pk2(float lo, float hi) { return f2bf(lo) | (f2bf(hi) << 16); }
__device__ __forceinline__ float bf2f(unsigned short b) { return __builtin_bit_cast(float, (unsigned)b << 16); }
__device__ __forceinline__ float bflo(unsigned w) { return __builtin_bit_cast(float, w << 16); }
__device__ __forceinline__ float bfhi(unsigned w) { return __builtin_bit_cast(float, w & 0xffff0000u); }

#define XB_TMO      128
#define XB_XCNT(j)  (256  + 64 * (j))
#define XB_XSUB(j)  (1280 + 64 * (j))
#define XB_XGEN(j)  (2304 + 64 * (j))
#define XB_TOP      3328
#define XB_TOPGEN   3392
#define XCD_BAR_WORDS 3456
#define XB_SPIN_CAP (1u << 18)

__device__ __forceinline__ unsigned xb_ld(GAS unsigned* p)              { return __hip_atomic_load(p, __ATOMIC_RELAXED, __HIP_MEMORY_SCOPE_AGENT); }
__device__ __forceinline__ unsigned xb_add(GAS unsigned* p, unsigned v) { return __hip_atomic_fetch_add(p, v, __ATOMIC_RELAXED, __HIP_MEMORY_SCOPE_AGENT); }
__device__ __forceinline__ unsigned xb_xcc_id() { return (unsigned)__builtin_amdgcn_s_getreg((3 << 11) | 20) & 0xFu; }
#define XB_SPIN(cond, bar) do { unsigned _sp = 0; while (cond) { __builtin_amdgcn_s_sleep(1); \
    if ((++_sp & 255u) == 0u) { if (xb_ld(&(bar)[XB_TMO])) break; if (_sp > XB_SPIN_CAP) { xb_add(&(bar)[XB_TMO], 1u); break; } } } } while (0)

struct XcdBarrier {
    GAS unsigned* bar; unsigned x;
    volatile LAS unsigned* st;
};
__device__ __forceinline__ XcdBarrier xcd_barrier_post(GAS unsigned* bar, volatile LAS unsigned* st, bool t0) {
    XcdBarrier b; b.bar = bar; b.x = xb_xcc_id(); b.st = st;
    if (t0) (void)xb_add(&bar[XB_XCNT(b.x)], 1u);
    return b;
}
__device__ __forceinline__ void xcd_barrier_complete(GAS unsigned* bar, unsigned x, unsigned& nloc, unsigned& nx) {
    const unsigned G = gridDim.x * gridDim.y * gridDim.z;
    unsigned sum, cnt, mine, sp = 0u;
    for (;;) {
        sum = 0u; cnt = 0u; mine = 0u;
#pragma unroll
        for (unsigned j = 0; j < 16; ++j) { const unsigned c = xb_ld(&bar[XB_XCNT(j)]); sum += c; cnt += (c > 0u) ? 1u : 0u; mine = (j == x) ? c : mine; }
        if (sum == G) break;
        __builtin_amdgcn_s_sleep(1);
        if ((++sp & 255u) == 0u) { if (xb_ld(&bar[XB_TMO])) break; if (sp > XB_SPIN_CAP) { xb_add(&bar[XB_TMO], 1u); break; } }
    }
    nloc = mine > 0u ? mine : 1u; nx = cnt > 0u ? cnt : 1u;
}
__device__ __forceinline__ void xcd_barrier(const XcdBarrier& b, bool t0) {
    asm volatile("s_waitcnt vmcnt(0)" ::: "memory");
    __syncthreads();
    if (t0) {
        GAS unsigned* bar = b.bar;
        __builtin_amdgcn_s_waitcnt(0);
        unsigned nloc = b.st[0], nx = b.st[1];
        if (nloc == 0u) { xcd_barrier_complete(bar, b.x, nloc, nx); b.st[0] = nloc; b.st[1] = nx; }
        const unsigned old = xb_add(&bar[XB_XSUB(b.x)], 1u);
        const unsigned gen = old / nloc;
        if (old + 1u == (gen + 1u) * nloc) {
            __builtin_amdgcn_fence(__ATOMIC_RELEASE, "agent");
            asm volatile("s_waitcnt vmcnt(0)" ::: "memory");
            const unsigned og = xb_add(&bar[XB_TOP], 1u);
            const unsigned tg = og / nx;
            if (og + 1u == (tg + 1u) * nx) xb_add(&bar[XB_TOPGEN], 1u);
            else XB_SPIN(xb_ld(&bar[XB_TOPGEN]) == tg, bar);
            __builtin_amdgcn_fence(__ATOMIC_ACQUIRE, "agent");
            xb_add(&bar[XB_XGEN(b.x)], 1u);
            asm volatile("s_waitcnt vmcnt(0)" ::: "memory");
        } else {
            XB_SPIN(xb_ld(&bar[XB_XGEN(b.x)]) == gen, bar);
            __builtin_amdgcn_fence(__ATOMIC_ACQUIRE, "agent");
            asm volatile("s_waitcnt vmcnt(0)" ::: "memory");
        }
    }
    __syncthreads();
}

struct Args { const float* in[30]; float* out; unsigned char* ws; int ph_lo, ph_hi; };
typedef const GAS float* cgf; typedef GAS float* gf; typedef const GAS bf16* cgb; typedef GAS bf16* gb; typedef GAS unsigned char* gu8; typedef const GAS char* cgc;

__device__ __forceinline__ unsigned long long tab_ld(LAS unsigned char* lds, int i) {
    const unsigned long long v = *(const LAS unsigned long long*)(lds + TAB_OFF + 8 * i);
    return ((unsigned long long)(unsigned)__builtin_amdgcn_readfirstlane((int)(unsigned)(v >> 32)) << 32) | (unsigned long long)(unsigned)__builtin_amdgcn_readfirstlane((int)(unsigned)v);
}
#define TIN(i) ((cgf)tab_ld(lds, (i)))
#define TOUT() ((gf)tab_ld(lds, 30))
#define TWS() ((gu8)tab_ld(lds, 31))

__device__ __forceinline__ float wave_sum(float v) {
#pragma unroll
    for (int o = 1; o < 64; o <<= 1) v += pg8::shx(v, o);
    return v;
}
__device__ __forceinline__ float wave_max(float v) {
#pragma unroll
    for (int o = 1; o < 64; o <<= 1) v = fmaxf(v, pg8::shx(v, o));
    return v;
}

__device__ __forceinline__ void p0_transpose_item(cgf W, int K, int N, gb WT, int k0, int n0, int orow0, LAS float* scr, int lane, cgf gain = nullptr) {
    if (gain) {
#pragma unroll 8
        for (int i = 0; i < 32; ++i) { const int kk = 2 * i + (lane >> 5); scr[kk * 33 + (lane & 31)] = W[(size_t)(k0 + kk) * N + n0 + (lane & 31)] * gain[k0 + kk]; }
    } else {
#pragma unroll 8
    for (int i = 0; i < 32; ++i) { const int kk = 2 * i + (lane >> 5); scr[kk * 33 + (lane & 31)] = W[(size_t)(k0 + kk) * N + n0 + (lane & 31)]; }
    }
    LDS_WAIT(); asm volatile("" ::: "memory");
    const int c = lane & 7;
#pragma unroll
    for (int j = 0; j < 4; ++j) { const int n = (lane >> 3) + 8 * j; const LAS float* s = scr + (8 * c) * 33 + n;
        v4u o; o.x = pk2(s[0 * 33], s[1 * 33]); o.y = pk2(s[2 * 33], s[3 * 33]); o.z = pk2(s[4 * 33], s[5 * 33]); o.w = pk2(s[6 * 33], s[7 * 33]);
        *(GAS v4u*)(WT + (size_t)(orow0 + n) * K + k0 + 8 * c) = o; }
    LDS_WAIT(); asm volatile("" ::: "memory");
}
__device__ __forceinline__ void p0_mat(cgf W, int K, int N, gb WT, int item, LAS float* scr, int lane, cgf gain = nullptr) {
    const int nblk = N / 32, kb = item / nblk, nb = item % nblk;
    p0_transpose_item(W, K, N, WT, 64 * kb, 32 * nb, 32 * nb, scr, lane, gain);
}
__device__ __forceinline__ void p0_mat_ffn_in(cgf W, gb WT, int item, LAS float* scr, int lane, cgf gain) {
    constexpr int N = 2 * DFF, nblk = N / 32; const int kb = item / nblk, nb = item % nblk; const int n0 = 32 * nb;
    const int j0 = (n0 < DFF) ? n0 : n0 - DFF; const int orow0 = (j0 >> 7) * 256 + (j0 & 127) + ((n0 < DFF) ? 0 : 128);
    p0_transpose_item(W, DM, N, WT, 64 * kb, n0, orow0, scr, lane, gain);
}
__device__ __forceinline__ void rms_row_to_bf16(cgf xrow, cgf g, gb orow, int lane) {
    const GAS f32x4* xr = (const GAS f32x4*)xrow + lane; const GAS f32x4* gr = (const GAS f32x4*)g + lane;
    f32x4 v[8]; float s = 0.f;
#pragma unroll
    for (int j = 0; j < 8; ++j) { v[j] = xr[64 * j]; s += (v[j].x * v[j].x + v[j].y * v[j].y) + (v[j].z * v[j].z + v[j].w * v[j].w); }
    const float rstd = 1.0f / sqrtf(wave_sum(s) * (1.f / DM) + EPS);
    GAS v2u* o8 = (GAS v2u*)orow + lane;
#pragma unroll
    for (int j = 0; j < 8; ++j) { const f32x4 gg = gr[64 * j]; v2u o; o.x = pk2(v[j].x * rstd * gg.x, v[j].y * rstd * gg.y); o.y = pk2(v[j].z * rstd * gg.z, v[j].w * rstd * gg.w); o8[64 * j] = o; }
}
__device__ __forceinline__ void x_row_init(cgf xrow, gb orow, gf rs, int lane) {
    float s = 0.f;
#pragma unroll
    for (int j = 0; j < 4; ++j) { const int col = j * 512 + lane * 8; const f32x4 a = *(const GAS f32x4*)(xrow + col), b = *(const GAS f32x4*)(xrow + col + 4);
        s += (a.x * a.x + a.y * a.y) + (a.z * a.z + a.w * a.w) + (b.x * b.x + b.y * b.y) + (b.z * b.z + b.w * b.w);
        v4u o; o.x = pk2(a.x, a.y); o.y = pk2(a.z, a.w); o.z = pk2(b.x, b.y); o.w = pk2(b.z, b.w); *(GAS v4u*)(orow + col) = o; }
    s = wave_sum(s);
    if (lane == 0) { *(GAS f32x4*)rs = (f32x4){s, 0.f, 0.f, 0.f}; *(GAS f32x4*)(rs + 4) = (f32x4){0.f, 0.f, 0.f, 0.f}; }
}
template <bool FIRST, bool LAST, bool SLABS>
__device__ __forceinline__ void t_row(cgf xf, cgb xh, cgb dh, cgf dsl, cgf g1, float c, gb xo, gf of, gf rs, int lane) {
    float x[32], d[32]; float s = 0.f;
#pragma unroll
    for (int j = 0; j < 4; ++j) { const int col = j * 512 + lane * 8;
        if constexpr (SLABS) { f32x4 a = *(const GAS f32x4*)(dsl + col), b = *(const GAS f32x4*)(dsl + col + 4);
#pragma unroll
            for (int sp = 1; sp < NSPLIT; ++sp) { a = a + *(const GAS f32x4*)(dsl + (size_t)sp * MS * DM + col); b = b + *(const GAS f32x4*)(dsl + (size_t)sp * MS * DM + col + 4); }
            d[8 * j + 0] = a.x; d[8 * j + 1] = a.y; d[8 * j + 2] = a.z; d[8 * j + 3] = a.w; d[8 * j + 4] = b.x; d[8 * j + 5] = b.y; d[8 * j + 6] = b.z; d[8 * j + 7] = b.w;
        } else { const v4u w = *(const GAS v4u*)(dh + col);
            d[8 * j + 0] = bflo(w.x); d[8 * j + 1] = bfhi(w.x); d[8 * j + 2] = bflo(w.y); d[8 * j + 3] = bfhi(w.y); d[8 * j + 4] = bflo(w.z); d[8 * j + 5] = bfhi(w.z); d[8 * j + 6] = bflo(w.w); d[8 * j + 7] = bfhi(w.w); }
        if constexpr (FIRST) { const f32x4 a = *(const GAS f32x4*)(xf + col), b = *(const GAS f32x4*)(xf + col + 4);
            x[8 * j + 0] = a.x; x[8 * j + 1] = a.y; x[8 * j + 2] = a.z; x[8 * j + 3] = a.w; x[8 * j + 4] = b.x; x[8 * j + 5] = b.y; x[8 * j + 6] = b.z; x[8 * j + 7] = b.w;
        } else { const v4u w = *(const GAS v4u*)(xh + col);
            x[8 * j + 0] = bflo(w.x); x[8 * j + 1] = bfhi(w.x); x[8 * j + 2] = bflo(w.y); x[8 * j + 3] = bfhi(w.y); x[8 * j + 4] = bflo(w.z); x[8 * j + 5] = bfhi(w.z); x[8 * j + 6] = bflo(w.w); x[8 * j + 7] = bfhi(w.w); } }
#pragma unroll
    for (int e = 0; e < 32; ++e) s += d[e] * d[e];
    const float rd = c / sqrtf(wave_sum(s) * (1.f / DM) + EPS);
    float s2 = 0.f;
#pragma unroll
    for (int j = 0; j < 4; ++j) { const int col = j * 512 + lane * 8; const f32x4 ga = *(const GAS f32x4*)(g1 + col), gb_ = *(const GAS f32x4*)(g1 + col + 4);
        x[8 * j + 0] += d[8 * j + 0] * rd * ga.x; x[8 * j + 1] += d[8 * j + 1] * rd * ga.y; x[8 * j + 2] += d[8 * j + 2] * rd * ga.z; x[8 * j + 3] += d[8 * j + 3] * rd * ga.w;
        x[8 * j + 4] += d[8 * j + 4] * rd * gb_.x; x[8 * j + 5] += d[8 * j + 5] * rd * gb_.y; x[8 * j + 6] += d[8 * j + 6] * rd * gb_.z; x[8 * j + 7] += d[8 * j + 7] * rd * gb_.w;
        if constexpr (LAST) { *(GAS f32x4*)(of + col) = (f32x4){x[8 * j + 0], x[8 * j + 1], x[8 * j + 2], x[8 * j + 3]}; *(GAS f32x4*)(of + col + 4) = (f32x4){x[8 * j + 4], x[8 * j + 5], x[8 * j + 6], x[8 * j + 7]}; }
        else { v4u o; o.x = pk2(x[8 * j + 0], x[8 * j + 1]); o.y = pk2(x[8 * j + 2], x[8 * j + 3]); o.z = pk2(x[8 * j + 4], x[8 * j + 5]); o.w = pk2(x[8 * j + 6], x[8 * j + 7]); *(GAS v4u*)(xo + col) = o;
#pragma unroll
            for (int e = 0; e < 8; ++e) s2 += x[8 * j + e] * x[8 * j + e]; } }
    if constexpr (!LAST) { s2 = wave_sum(s2); if (lane == 0) *rs = 1.0f / sqrtf(s2 * (1.f / DM) + EPS); }
}

__device__ __forceinline__ void ksplit(int K, int s, int& koff, int& kt) {
    if (K == 2048) { koff = s * 256; kt = 4; }
    else { if (s < 3) { koff = s * 768; kt = 12; } else { koff = 2304 + (s - 3) * 640; kt = 10; } }
}
template <bool MIX>
struct SchedSplit {
    cgc A; cgc B; int lda, ldb, nN, K, G, c;
    __device__ __forceinline__ bool next(int i, pg8::GUnit& u) const {
        int L = i * G + c; const int NP = 32 * nN; int pm, pn;
        if (L < NP) { pg8::tile_of(L, 32, nN, pm, pn);
            u.a = A + (size_t)pm * 256 * lda * 2; u.b = B + (size_t)pn * 256 * ldb * 2; u.orow = pm * 256; u.nt = K / 64;
            if (MIX) { u.ocol = (pn & 3) * 256; u.kind = pn >> 2; } else { u.ocol = pn * 256; u.kind = 0; }
            return true; }
        L -= NP; if (L >= 2 * nN * NSPLIT) return false;
        const int sp = L & (NSPLIT - 1), tile = L >> 3; pm = tile & 1; pn = tile >> 1;
        int koff, kt; ksplit(K, sp, koff, kt);
        u.a = A + ((size_t)(MP + pm * 256) * lda + koff) * 2; u.b = B + ((size_t)pn * 256 * ldb + koff) * 2;
        u.orow = sp * MS + pm * 256; u.ocol = pn * 256; u.kind = pg8::KIND_SLAB; u.nt = kt; return true;
    }
};
struct SchedMixIn {
    cgc A; cgc B; int G, c;
    __device__ __forceinline__ bool next(int i, pg8::GUnit& u) const {
        const int L = i * G + c; if (L >= (MT / 256) * 16) return false;
        int pm, pn; pg8::tile_of(L, MT / 256, 16, pm, pn);
        u.a = A + (size_t)pm * 256 * DM * 2; u.b = B + (size_t)pn * 256 * DM * 2; u.orow = pm * 256; u.ocol = (pn & 3) * 256; u.kind = pn >> 2; u.nt = DM / 64; return true;
    }
};
template <bool MIX>
struct SchedStrip {
    cgc A; cgc B; int lda, ldb, nN, K, G, c;
    __device__ __forceinline__ bool next(int i, pg8::GUnit& u) const {
        const int L = i * G + c; if (L >= 32 * nN) return false;
        int pm, pn; pg8::tile_of(L, 32, nN, pm, pn);
        u.a = A + (size_t)pm * 256 * lda * 2; u.sd = (MP + 16 * pm - 256 * pm) * lda * 2; u.srow = MP + 16 * pm; u.b = B + (size_t)pn * 256 * ldb * 2; u.orow = pm * 256; u.nt = K / 64;
        if (MIX) { u.ocol = (pn & 3) * 256; u.kind = pn >> 2; } else { u.ocol = pn * 256; u.kind = 0; }
        return true;
    }
};
struct SchedFfnIn {
    cgc H; cgc W; cgc MEMN; cgc WKV; int G, c, with_kv;
    static constexpr size_t TS = (size_t)256 * DM * 2;
    __device__ __forceinline__ bool next(int i, pg8::GUnit& u) const {
        int L = i * G + c; int pm, pn; u.nt = DM / 64; u.sd = 0; u.srow = 0;
        constexpr int N0 = (MT / 256) * (2 * DFF / 256), N1 = 32;
        if (L < N0) { pg8::tile_of(L, MT / 256, 2 * DFF / 256, pm, pn); u.a = H + pm * TS; u.b = W + pn * TS; u.orow = pm * 256; u.ocol = pn * 128; u.kind = 0; return true; }
        if (!with_kv) return false;
        L -= N0;
        if (L < N1) { pm = L & 3; pn = L >> 2; u.a = MEMN + pm * TS; u.b = WKV + pn * TS; u.orow = pm * 256; u.ocol = pn * 256; u.kind = 1; return true; }
        L -= N1;
        if (L < N1) { pm = L >> 2; pn = L & 3; u.a = WKV + (8 + pm) * TS; u.b = MEMN + pn * TS; u.orow = pm * 256; u.ocol = pn * 256; u.kind = 2; return true; }
        return false;
    }
};
struct SchedX1 {
    cgc Q; cgc KB; int G, c;
    __device__ __forceinline__ bool next(int i, pg8::GUnit& u) const {
        const int L = i * G + c; if (L >= NB * XAH * 8) return false;
        const int qb = L & 7, h = (L >> 3) & 3, n = L >> 5;
        u.a = Q + ((size_t)(n * SEQ + qb * 256) * DM + h * XAD) * 2; u.b = KB + ((size_t)(n * MEML) * DM + h * XAD) * 2;
        u.orow = n * SEQ + qb * 256; u.ocol = h * 256; u.kind = 0; u.nt = XAD / 64; u.sd = 0; u.srow = 0; return true;
    }
};
struct SchedX2 {
    cgc P; cgc VT; int G, c;
    __device__ __forceinline__ bool next(int i, pg8::GUnit& u) const {
        const int L = i * G + c; if (L >= NB * XAH * 8 * 2) return false;
        const int pn = L & 1, qb = (L >> 1) & 7, h = (L >> 4) & 3, n = L >> 6;
        u.a = P + ((size_t)(n * SEQ + qb * 256) * 1024 + h * 256) * 2; u.b = VT + ((size_t)(h * XAD + pn * 256) * 1024 + n * MEML) * 2;
        u.orow = n * SEQ + qb * 256; u.ocol = h * XAD + pn * 256; u.kind = 0; u.nt = MEML / 64; u.sd = 0; u.srow = 0; return true;
    }
};
struct SchedX2pair {
    cgc P; cgc VT; int cc;
    __device__ __forceinline__ bool next(int i, pg8::GUnit& u) const {
        if (cc < 0 || i >= 2) return false;
        const int pn = i, qb = cc & 7, h = (cc >> 3) & 3, n = cc >> 5;
        u.a = P + ((size_t)(n * SEQ + qb * 256) * 1024 + h * 256) * 2; u.b = VT + ((size_t)(h * XAD + pn * 256) * 1024 + n * MEML) * 2;
        u.orow = n * SEQ + qb * 256; u.ocol = h * XAD + pn * 256; u.kind = 0; u.nt = MEML / 64; u.sd = 0; u.srow = 0; return true;
    }
};

constexpr int LR_XC = 0;
constexpr int LR_A = 67584;
constexpr int LR_W = LR_A + 34816;
constexpr int LR_AA = LR_A;
constexpr int LR_SEG = LR_W + 34816;
constexpr int LR_PAR = LR_SEG + 4096;
static_assert(LR_AA + 67584 <= LR_SEG && LR_PAR + 1536 <= TAB_OFF, "LRU LDS map");

template <bool SAMPLE>
__device__ __forceinline__ void lru_unit(LAS unsigned char* lds, int l, int ui, int tid, int wave, int lane) {
    const int h = ui & 7, ch0 = h * 128;
    const int cidx = SAMPLE ? 0 : ((ui >> 3) & 15), n = SAMPLE ? 0 : (ui >> 7), blk = SAMPLE ? (ui >> 3) : 0;
    const int row0 = SAMPLE ? (MP + blk * 128) : (n * SEQ + cidx * 128);
    LAS float* XC = (LAS float*)(lds + LR_XC); LAS bf16* At = (LAS bf16*)(lds + LR_A); LAS bf16* Wt = (LAS bf16*)(lds + LR_W);
    LAS float* AA = (LAS float*)(lds + LR_AA); LAS float* SEG = (LAS float*)(lds + LR_SEG); LAS float* PAR = (LAS float*)(lds + LR_PAR);
    const int ch = tid & 127, rg = tid >> 7;
    const gu8 ws = TWS(); const gf out = TOUT();
    v4u wa_r[4], wi_r[4];
    { const GAS v4u* sa = (const GAS v4u*)(ws + WS_W + (size_t)l * WL_SIZE + WL_LRA + (size_t)h * 32768); const GAS v4u* si = (const GAS v4u*)(ws + WS_W + (size_t)l * WL_SIZE + WL_LRI + (size_t)h * 32768);
#pragma unroll
      for (int j = 0; j < 4; ++j) { wa_r[j] = sa[tid + 512 * j]; wi_r[j] = si[tid + 512 * j]; } }
    if (tid < 128) { PAR[tid] = TIN(15)[(size_t)l * DLRU + ch0 + tid]; PAR[128 + tid] = TIN(17)[(size_t)l * DLRU + ch0 + tid]; const float lm = TIN(18)[(size_t)l * DLRU + ch0 + tid]; PAR[256 + tid] = -8.0f * log1pf(expf(-lm)); }
    {
        const cgf cw = TIN(12) + (size_t)l * 4 * DLRU + ch0 + ch;
        const float w0 = cw[0], w1 = cw[DLRU], w2 = cw[2 * DLRU], w3 = cw[3 * DLRU], cbv = TIN(13)[(size_t)l * DLRU + ch0 + ch];
        const cgf xp = (cgf)(ws + WS_XL) + (size_t)(row0 + rg * 32) * DLRU + ch0 + ch;
        if constexpr (!SAMPLE) {
            float xm3 = 0.f, xm2 = 0.f, xm1 = 0.f;
            if (cidx > 0 || rg > 0) { xm3 = xp[-3 * DLRU]; xm2 = xp[-2 * DLRU]; xm1 = xp[-1 * DLRU]; }
            float xv[32];
#pragma unroll
            for (int r = 0; r < 32; ++r) xv[r] = xp[(size_t)r * DLRU];
#pragma unroll
            for (int r = 0; r < 32; ++r) { const float x0 = xv[r]; const float xc = cbv + w3 * x0 + w2 * xm1 + w1 * xm2 + w0 * xm3;
                XC[(rg * 32 + r) * 132 + ch] = xc; At[(rg * 32 + r) * 136 + ch] = (bf16)f2bf(xc); xm3 = xm2; xm2 = xm1; xm1 = x0; }
            if (cidx == 15 && rg == 3) { const gf o = out + OUT_CVP + ((size_t)l * NB + n) * 3 * DLRU + ch0 + ch; o[0] = xm3; o[DLRU] = xm2; o[2 * DLRU] = xm1; }
        } else {
#pragma unroll 2
            for (int e = 0; e < 8; ++e) { const int nb = blk * 32 + rg * 8 + e; const cgf sc = TIN(5) + ((size_t)l * DECB + nb) * 3 * DLRU + ch0 + ch;
                float xm3 = sc[0], xm2 = sc[DLRU], xm1 = sc[2 * DLRU];
#pragma unroll
                for (int t = 0; t < 4; ++t) { const int r = e * 4 + t; const float x0 = xp[(size_t)r * DLRU]; const float xc = cbv + w3 * x0 + w2 * xm1 + w1 * xm2 + w0 * xm3;
                    XC[(rg * 32 + r) * 132 + ch] = xc; At[(rg * 32 + r) * 136 + ch] = (bf16)f2bf(xc); xm3 = xm2; xm2 = xm1; xm1 = x0; }
                const gf o = out + OUT_CVS + ((size_t)l * DECB + nb) * 3 * DLRU + ch0 + ch; o[0] = xm3; o[DLRU] = xm2; o[2 * DLRU] = xm1; }
        }
    }
    const int fr = lane & 15, fq = lane >> 4;
    pg8::f32x4 acc_a[8], acc_i[8];
#pragma unroll
    for (int ct = 0; ct < 8; ++ct) { acc_a[ct] = (pg8::f32x4){0.f, 0.f, 0.f, 0.f}; acc_i[ct] = (pg8::f32x4){0.f, 0.f, 0.f, 0.f}; }
    {
#pragma unroll
        for (int j = 0; j < 4; ++j) { const int q = tid + 512 * j; *(LAS v4u*)(Wt + (q >> 4) * 136 + (q & 15) * 8) = wa_r[j]; }
    }
    LDS_WAIT(); __syncthreads();
    bf16x8 af[4];
#pragma unroll
    for (int ks = 0; ks < 4; ++ks) af[ks] = *(const LAS bf16x8*)(At + (wave * 16 + fr) * 136 + ks * 32 + fq * 8);
#pragma unroll
    for (int ct = 0; ct < 8; ++ct)
#pragma unroll
        for (int ks = 0; ks < 4; ++ks) { const bf16x8 bfr = *(const LAS bf16x8*)(Wt + (ct * 16 + fr) * 136 + ks * 32 + fq * 8); acc_a[ct] = __builtin_amdgcn_mfma_f32_16x16x32_bf16(bfr, af[ks], acc_a[ct], 0, 0, 0); }
    LDS_WAIT(); __syncthreads();
    {
#pragma unroll
        for (int j = 0; j < 4; ++j) { const int q = tid + 512 * j; *(LAS v4u*)(Wt + (q >> 4) * 136 + (q & 15) * 8) = wi_r[j]; }
    }
    LDS_WAIT(); __syncthreads();
#pragma unroll
    for (int ct = 0; ct < 8; ++ct)
#pragma unroll
        for (int ks = 0; ks < 4; ++ks) { const bf16x8 bfr = *(const LAS bf16x8*)(Wt + (ct * 16 + fr) * 136 + ks * 32 + fq * 8); acc_i[ct] = __builtin_amdgcn_mfma_f32_16x16x32_bf16(bfr, af[ks], acc_i[ct], 0, 0, 0); }
    LDS_WAIT(); __syncthreads();
    {
        const int row = wave * 16 + fr;
#pragma unroll
        for (int ct = 0; ct < 8; ++ct) { const int c4 = ct * 16 + fq * 4;
            const pg8::f32x4 bav = *(const LAS pg8::f32x4*)(PAR + c4), biv = *(const LAS pg8::f32x4*)(PAR + 128 + c4), clv = *(const LAS pg8::f32x4*)(PAR + 256 + c4);
            const pg8::f32x4 xcv = *(const LAS pg8::f32x4*)(XC + row * 132 + c4); pg8::f32x4 av, bv;
#pragma unroll
            for (int j = 0; j < 4; ++j) { const float r = pg8::fast_sigmoid(acc_a[ct][j] + bav[j]), ig = pg8::fast_sigmoid(acc_i[ct][j] + biv[j]);
                const float la = clv[j] * r; const float a = __builtin_amdgcn_exp2f(1.44269504089f * la); av[j] = a;
                const float z = 2.0f * la; const float om = (z > -0.0625f) ? -z * (1.0f + z * (0.5f + z * (0.16666667f + z * 0.041666668f))) : (1.0f - a * a);
                bv[j] = __builtin_amdgcn_sqrtf(om) * (ig * xcv[j]); }
            *(LAS pg8::f32x4*)(AA + row * 132 + c4) = av; *(LAS pg8::f32x4*)(XC + row * 132 + c4) = bv; }
    }
    LDS_WAIT(); __syncthreads();
    if constexpr (!SAMPLE) {
        float hh = 0.f, pp = 1.f;
#pragma unroll 8
        for (int r = 0; r < 32; ++r) { const float a = AA[(rg * 32 + r) * 132 + ch], b = XC[(rg * 32 + r) * 132 + ch]; hh = a * hh + b; pp *= a; }
        SEG[tid * 2] = pp; SEG[tid * 2 + 1] = hh;
        LDS_WAIT(); __syncthreads();
        unsigned short gv[32];
        { const cgb GLp = (cgb)(ws + WS_GL) + (size_t)(row0 + rg * 32) * DLRU + ch0 + ch;
#pragma unroll
          for (int r = 0; r < 32; ++r) gv[r] = GLp[(size_t)r * DLRU]; }
        const int uidx = ((n * 8 + h) << 4) + cidx;
        GAS unsigned long long* cs = (GAS unsigned long long*)(ws + WS_CS) + ((size_t)l * 512 + uidx) * 128;
        gu32* flg = (gu32*)(ws + WS_CTL) + CW_LRUF + (l * 512 + ((n * 8 + h) << 4)) * 16;
        if (rg == 3) { float P = 1.f, Hh = 0.f;
#pragma unroll
            for (int sg = 0; sg < 4; ++sg) { const float ps = SEG[(sg * 128 + ch) * 2], hs = SEG[(sg * 128 + ch) * 2 + 1]; Hh = ps * Hh + hs; P *= ps; }
            __hip_atomic_store(cs + ch, ((unsigned long long)__float_as_uint(Hh) << 32) | (unsigned long long)__float_as_uint(P), RLX_AGENT); }
        VM_WAIT(); __syncthreads();
        if (tid == 0) __hip_atomic_store(flg + 16 * cidx, 1u, RLX_AGENT);
        if (cidx > 0) {
            if (wave == 0) { unsigned spins = 0;
                for (;;) { bool ok = true; if (lane < cidx) ok = __hip_atomic_load(flg + 16 * lane, RLX_AGENT) != 0u;
                    if (__all(ok)) break; __builtin_amdgcn_s_sleep(2); if (++spins > (1u << 20)) break; }
                __builtin_amdgcn_fence(__ATOMIC_ACQUIRE, "agent"); VM_WAIT(); }
            __syncthreads();
        }
        hh = 0.f;
        for (int j = 0; j < cidx; ++j) { const unsigned long long v = __hip_atomic_load(cs - (size_t)(cidx - j) * 128 + ch, RLX_AGENT); hh = __uint_as_float((unsigned)v) * hh + __uint_as_float((unsigned)(v >> 32)); }
        for (int sg = 0; sg < rg; ++sg) { const float ps = SEG[(sg * 128 + ch) * 2], hs = SEG[(sg * 128 + ch) * 2 + 1]; hh = ps * hh + hs; }
        {
            const gb Y = (gb)(ws + WS_YMIX) + (size_t)(row0 + rg * 32) * DM + ch0 + ch;
#pragma unroll
            for (int r = 0; r < 32; ++r) { const float a = AA[(rg * 32 + r) * 132 + ch], b = XC[(rg * 32 + r) * 132 + ch]; hh = a * hh + b; Y[(size_t)r * DM] = (bf16)f2bf(hh * bf2f(gv[r])); }
            if (cidx == 15 && rg == 3) out[OUT_HP + ((size_t)l * NB + n) * DLRU + ch0 + ch] = hh;
        }
    } else {
        const cgb GLp = (cgb)(ws + WS_GL); const gb YMIX = (gb)(ws + WS_YMIX);
#pragma unroll 2
        for (int e = 0; e < 8; ++e) { const int nb = blk * 32 + rg * 8 + e; float hh = TIN(6)[((size_t)l * DECB + nb) * DLRU + ch0 + ch];
#pragma unroll
            for (int t = 0; t < 4; ++t) { const int r = rg * 32 + e * 4 + t; const float a = AA[r * 132 + ch], b = XC[r * 132 + ch]; hh = a * hh + b;
                const size_t m = (size_t)(row0 + r); const float g = bf2f(GLp[m * DLRU + ch0 + ch]); YMIX[m * DM + ch0 + ch] = (bf16)f2bf(hh * g); }
            out[OUT_HS + ((size_t)l * DECB + nb) * DLRU + ch0 + ch] = hh; }
    }
    LDS_WAIT(); __syncthreads();
}

constexpr int SG_A = 0;
constexpr int SG_B = 34816;
constexpr int SG_ST = 69632;

__device__ __forceinline__ void sgu_unit(LAS unsigned char* lds, int l, int ui, int tid, int wave, int lane) {
    const int g = ui & 7, cidx = (ui >> 3) & 15, n = ui >> 7; const int row0 = n * SEQ + cidx * 128, col0 = g * 128;
    LAS bf16* At = (LAS bf16*)(lds + SG_A); LAS bf16* Bt = (LAS bf16*)(lds + SG_B); LAS float* ST = (LAS float*)(lds + SG_ST);
    const gu8 ws = TWS();
    v2u ur[8];
    { const cgb UGp = (cgb)(ws + WS_UG) + (size_t)(row0 + wave * 16 + (lane & 15)) * DSGU + col0 + (lane >> 4) * 4;
#pragma unroll
      for (int ct = 0; ct < 8; ++ct) ur[ct] = *(const GAS v2u*)(UGp + ct * 16); }
    if (tid < 128) { const GAS f32x4* p = (const GAS f32x4*)((cgf)(ws + WS_VST) + (size_t)(row0 + tid) * 32); float s = 0.f, q = 0.f;
#pragma unroll
        for (int j = 0; j < 8; ++j) { const f32x4 v = p[j]; s += v.x + v.z; q += v.y + v.w; }
        const float mean = s * (1.f / DSGU); const float var = fmaxf(q * (1.f / DSGU) - mean * mean, 0.f); ST[tid * 2] = mean; ST[tid * 2 + 1] = 1.0f / sqrtf(var + EPS); }
    {
        const GAS v4u* src = (const GAS v4u*)(ws + WS_W + (size_t)l * WL_SIZE + WL_SGW + (size_t)g * 32768);
#pragma unroll
        for (int j = 0; j < 4; ++j) { const int q = tid + 512 * j; *(LAS v4u*)(At + (q >> 4) * 136 + (q & 15) * 8) = src[q]; }
    }
    LDS_WAIT(); __syncthreads();
    {
        const int s = tid >> 2, dq = tid & 3; const float mean = ST[s * 2], rstd = ST[s * 2 + 1];
        const GAS f32x4* vp = (const GAS f32x4*)((cgf)(ws + WS_VG) + (size_t)(row0 + s) * DSGU + col0 + dq * 32);
        const GAS f32x4* gp = (const GAS f32x4*)(TIN(19) + ((size_t)l * 2 + 0) * DSGU + col0 + dq * 32); const GAS f32x4* bp = (const GAS f32x4*)(TIN(19) + ((size_t)l * 2 + 1) * DSGU + col0 + dq * 32);
#pragma unroll
        for (int jj = 0; jj < 8; ++jj) { const f32x4 v = vp[jj], gg = gp[jj], bb = bp[jj];
#pragma unroll
            for (int e = 0; e < 4; ++e) Bt[(dq * 32 + jj * 4 + e) * 136 + s] = (bf16)f2bf((v[e] - mean) * rstd * gg[e] + bb[e]); }
    }
    LDS_WAIT(); __syncthreads();
    const int fr = lane & 15, fq = lane >> 4;
    pg8::f32x4 acc[8];
#pragma unroll
    for (int ct = 0; ct < 8; ++ct) acc[ct] = (pg8::f32x4){0.f, 0.f, 0.f, 0.f};
    bf16x8 af[4];
#pragma unroll
    for (int ks = 0; ks < 4; ++ks) af[ks] = *(const LAS bf16x8*)(At + (wave * 16 + fr) * 136 + ks * 32 + fq * 8);
#pragma unroll
    for (int ct = 0; ct < 8; ++ct)
#pragma unroll
        for (int ks = 0; ks < 4; ++ks) { const bf16x8 bfr = *(const LAS bf16x8*)(Bt + (ct * 16 + fr) * 136 + ks * 32 + fq * 8); acc[ct] = __builtin_amdgcn_mfma_f32_16x16x32_bf16(bfr, af[ks], acc[ct], 0, 0, 0); }
    {
        const int t = wave * 16 + fr; const float bias = TIN(21)[((size_t)l * 8 + g) * CHUNK + t]; const size_t m = (size_t)(row0 + t);
        const gb YMIX = (gb)(ws + WS_YMIX);
#pragma unroll
        for (int ct = 0; ct < 8; ++ct) { const int d = ct * 16 + fq * 4; const v2u uw = ur[ct];
            v2u o; o.x = pg8::cvt_pk_bf16(bflo(uw.x) * (acc[ct][0] + bias), bfhi(uw.x) * (acc[ct][1] + bias)); o.y = pg8::cvt_pk_bf16(bflo(uw.y) * (acc[ct][2] + bias), bfhi(uw.y) * (acc[ct][3] + bias));
            *(GAS v2u*)(YMIX + m * DM + DLRU + col0 + d) = o; }
    }
    LDS_WAIT(); __syncthreads();
}
__device__ __forceinline__ void sgu_sample_item(LAS unsigned char* lds, int l, int nb, int lane) {
    float vn[4][16];
    const int cbase = lane * 16;
    const gu8 ws = TWS(); const gf out = TOUT();
    const cgf lng = TIN(19) + ((size_t)l * 2 + 0) * DSGU + cbase; const cgf lnb = TIN(19) + ((size_t)l * 2 + 1) * DSGU + cbase;
#pragma unroll
    for (int t = 0; t < 4; ++t) { const size_t m = (size_t)(MP + nb * 4 + t);
        const GAS f32x4* vp = (const GAS f32x4*)((cgf)(ws + WS_VG) + m * DSGU + cbase); const GAS f32x4* gp = (const GAS f32x4*)lng; const GAS f32x4* bp = (const GAS f32x4*)lnb;
        f32x4 v[4]; float sm = 0.f;
#pragma unroll
        for (int j = 0; j < 4; ++j) { v[j] = vp[j]; sm += (v[j].x + v[j].y) + (v[j].z + v[j].w); }
        const float mean = wave_sum(sm) * (1.f / DSGU); float sq = 0.f;
#pragma unroll
        for (int j = 0; j < 4; ++j)
#pragma unroll
            for (int e = 0; e < 4; ++e) { const float d = v[j][e] - mean; sq += d * d; }
        const float rstd = 1.0f / sqrtf(wave_sum(sq) * (1.f / DSGU) + EPS);
        GAS f32x4* op = (GAS f32x4*)(out + OUT_VS + (((size_t)l * DECB + nb) * 4 + t) * DSGU + cbase);
#pragma unroll
        for (int j = 0; j < 4; ++j) { const f32x4 gg = gp[j], bb = bp[j]; f32x4 o;
#pragma unroll
            for (int e = 0; e < 4; ++e) { o[e] = (v[j][e] - mean) * rstd * gg[e] + bb[e]; vn[t][j * 4 + e] = o[e]; }
            op[j] = o; } }
    const int g = cbase >> 7;
    const cgf sgw = TIN(20) + ((size_t)l * 8 + g) * 16384; const cgf sgb = TIN(21) + ((size_t)l * 8 + g) * CHUNK;
#pragma unroll
    for (int t = 0; t < 4; ++t) { const size_t m = (size_t)(MP + nb * 4 + t); const float bias = sgb[t];
        float w[4];
#pragma unroll
        for (int s = 0; s < 4; ++s) w[s] = (s <= t) ? sgw[t * 128 + s] : 0.f;
        const GAS v4u* up = (const GAS v4u*)((cgb)(ws + WS_UG) + m * DSGU + cbase); GAS v4u* yp = (GAS v4u*)((gb)(ws + WS_YMIX) + m * DM + DLRU + cbase);
#pragma unroll
        for (int j = 0; j < 2; ++j) { const v4u uw = up[j]; float sv[8];
#pragma unroll
            for (int e = 0; e < 8; ++e) { float acc = bias;
#pragma unroll
                for (int s = 0; s < 4; ++s) acc += w[s] * vn[s][j * 8 + e];
                sv[e] = acc; }
            v4u o; o.x = pk2(bflo(uw.x) * sv[0], bfhi(uw.x) * sv[1]); o.y = pk2(bflo(uw.y) * sv[2], bfhi(uw.y) * sv[3]); o.z = pk2(bflo(uw.z) * sv[4], bfhi(uw.z) * sv[5]); o.w = pk2(bflo(uw.w) * sv[6], bfhi(uw.w) * sv[7]);
            yp[j] = o; } }
}

__device__ __forceinline__ void lru_fix_unit(LAS unsigned char* lds, int l, int ui, int wave, int lane) {
    const int qd = ui & 3, cidx = (ui >> 2) & 15, n = ui >> 6; const int cch = qd * 256 + lane * 4;
    const gu8 ws = TWS();
    const cgf HLOC = (cgf)(ws + WS_HLOC), PC = (cgf)(ws + WS_PC), CSUM = (cgf)(ws + WS_CSUM); const cgb GLp = (cgb)(ws + WS_GL); const gb YMIX = (gb)(ws + WS_YMIX);
    f32x4 H = (f32x4){0.f, 0.f, 0.f, 0.f};
    for (int j = 0; j < cidx; ++j) { const GAS f32x4* cs = (const GAS f32x4*)(CSUM + ((size_t)(n * 16 + j) * DLRU + cch) * 2); const f32x4 c0 = cs[0], c1 = cs[1];
        H.x = c0.x * H.x + c0.y; H.y = c0.z * H.y + c0.w; H.z = c1.x * H.z + c1.y; H.w = c1.z * H.w + c1.w; }
#pragma unroll 4
    for (int r = 0; r < 16; ++r) { const int t = cidx * 128 + wave * 16 + r; const size_t m = (size_t)(n * SEQ + t);
        const f32x4 hl = *(const GAS f32x4*)(HLOC + m * DLRU + cch), pc = *(const GAS f32x4*)(PC + m * DLRU + cch); const v2u gw = *(const GAS v2u*)(GLp + m * DLRU + cch);
        const f32x4 hv = hl + pc * H;
        v2u o; o.x = pk2(hv.x * bflo(gw.x), hv.y * bfhi(gw.x)); o.y = pk2(hv.z * bflo(gw.y), hv.w * bfhi(gw.y));
        *(GAS v2u*)(YMIX + m * DM + cch) = o;
        if (t == SEQ - 1) *(GAS f32x4*)(TOUT() + OUT_HP + ((size_t)l * NB + n) * DLRU + cch) = hv; }
}

constexpr int SA_SC = 0;
constexpr int SA_O = 4096;
__device__ __forceinline__ void sattn_unit(LAS unsigned char* lds, int l, int ui, int tid, int wave, int lane) {
    const int h = ui & 3, nb = ui >> 2;
    LAS float* SC = (LAS float*)(lds + SA_SC); LAS float* OA = (LAS float*)(lds + SA_O);
    const gu8 ws = TWS();
    const cgf kbase = TIN(3) + (((size_t)l * DECB + nb) * MEML * XAH + h) * XAD + lane * 8;
    {
        float q[4][8];
#pragma unroll
        for (int t = 0; t < 4; ++t) { const v4u w = *(const GAS v4u*)((cgb)(ws + WS_QB) + (size_t)(MP + nb * 4 + t) * DM + h * XAD + lane * 8);
            q[t][0] = bflo(w.x); q[t][1] = bfhi(w.x); q[t][2] = bflo(w.y); q[t][3] = bfhi(w.y); q[t][4] = bflo(w.z); q[t][5] = bfhi(w.z); q[t][6] = bflo(w.w); q[t][7] = bfhi(w.w); }
#pragma unroll 1
        for (int kb = 0; kb < 4; ++kb) {
            const int key0 = wave * 32 + kb * 8;
            f32x4 kv[8][2];
#pragma unroll
            for (int j = 0; j < 8; ++j) { const GAS f32x4* kp = (const GAS f32x4*)(kbase + (size_t)(key0 + j) * (XAH * XAD)); kv[j][0] = kp[0]; kv[j][1] = kp[1]; }
            float v[32];
#pragma unroll
            for (int j = 0; j < 8; ++j)
#pragma unroll
                for (int t = 0; t < 4; ++t) { v[j * 4 + t] = (q[t][0] * kv[j][0].x + q[t][1] * kv[j][0].y) + (q[t][2] * kv[j][0].z + q[t][3] * kv[j][0].w) + (q[t][4] * kv[j][1].x + q[t][5] * kv[j][1].y) + (q[t][6] * kv[j][1].z + q[t][7] * kv[j][1].w); }
#pragma unroll
            for (int j = 0; j < 32; ++j) v[j] += pg8::shx(v[j], 32);
#pragma unroll
            for (int s = 0; s < 5; ++s) { const int off = 16 >> s; const bool up = (lane & off) != 0;
#pragma unroll
                for (int j = 0; j < (16 >> s); ++j) { const float keep = up ? v[j + off] : v[j]; const float send = up ? v[j] : v[j + off]; v[j] = keep + pg8::shx(send, off); } }
            if (lane < 32) SC[(lane & 3) * 256 + key0 + (lane >> 2)] = v[0];
        }
    }
    LDS_WAIT(); __syncthreads();
    if (wave < 4) { const float sl2 = 0.04419417382f * 1.44269504089f; f32x4 s = *(const LAS f32x4*)(SC + wave * 256 + lane * 4);
        const float mx = wave_max(fmaxf(fmaxf(s.x, s.y), fmaxf(s.z, s.w))) * sl2;
        s.x = __builtin_amdgcn_exp2f(s.x * sl2 - mx); s.y = __builtin_amdgcn_exp2f(s.y * sl2 - mx); s.z = __builtin_amdgcn_exp2f(s.z * sl2 - mx); s.w = __builtin_amdgcn_exp2f(s.w * sl2 - mx);
        const float inv = 1.0f / wave_sum((s.x + s.y) + (s.z + s.w));
        *(LAS f32x4*)(SC + wave * 256 + lane * 4) = s * inv; }
    LDS_WAIT(); __syncthreads();
    {
        const cgf vbase = TIN(4) + (((size_t)l * DECB + nb) * MEML * XAH + h) * XAD + lane * 8;
        float o[4][8];
#pragma unroll
        for (int t = 0; t < 4; ++t)
#pragma unroll
            for (int e = 0; e < 8; ++e) o[t][e] = 0.f;
#pragma unroll 1
        for (int kb = 0; kb < 4; ++kb) {
            const int key0 = wave * 32 + kb * 8;
            f32x4 vv[8][2];
#pragma unroll
            for (int j = 0; j < 8; ++j) { const GAS f32x4* vp = (const GAS f32x4*)(vbase + (size_t)(key0 + j) * (XAH * XAD)); vv[j][0] = vp[0]; vv[j][1] = vp[1]; }
#pragma unroll
            for (int j = 0; j < 8; ++j)
#pragma unroll
                for (int t = 0; t < 4; ++t) { const float p = SC[t * 256 + key0 + j];
                    o[t][0] += p * vv[j][0].x; o[t][1] += p * vv[j][0].y; o[t][2] += p * vv[j][0].z; o[t][3] += p * vv[j][0].w; o[t][4] += p * vv[j][1].x; o[t][5] += p * vv[j][1].y; o[t][6] += p * vv[j][1].z; o[t][7] += p * vv[j][1].w; }
        }
#pragma unroll
        for (int t = 0; t < 4; ++t) { *(LAS f32x4*)(OA + (wave * 4 + t) * 512 + lane * 8) = (f32x4){o[t][0], o[t][1], o[t][2], o[t][3]}; *(LAS f32x4*)(OA + (wave * 4 + t) * 512 + lane * 8 + 4) = (f32x4){o[t][4], o[t][5], o[t][6], o[t][7]}; }
    }
    LDS_WAIT(); __syncthreads();
    {
        const int t = tid >> 7, d = (tid & 127) * 4; f32x4 s = (f32x4){0.f, 0.f, 0.f, 0.f};
#pragma unroll
        for (int w = 0; w < 8; ++w) s = s + *(const LAS f32x4*)(OA + (w * 4 + t) * 512 + d);
        v2u ov; ov.x = pk2(s.x, s.y); ov.y = pk2(s.z, s.w);
        *(GAS v2u*)((gb)(ws + WS_OB) + (size_t)(MP + nb * 4 + t) * DM + h * XAD + d) = ov;
    }
    LDS_WAIT(); __syncthreads();
}

constexpr int NPHASES = 1 + 16 * DEPTH;

__global__ void __launch_bounds__(NWAVES * 64, 2) fwd(Args args) {
    extern __shared__ __attribute__((aligned(16))) unsigned char lds_raw[];
    LAS unsigned char* lds = (LAS unsigned char*)lds_raw;
    volatile LAS unsigned* MISC = (volatile LAS unsigned*)(lds + MISC_OFF);
    const int G = gridDim.x, bx = blockIdx.x;
    const int wave_s = __builtin_amdgcn_readfirstlane((int)(threadIdx.x >> 6));
#define PHASE_IDS() int tid = wave_s * 64 + pg8::lane_id(); asm volatile("" : "+v"(tid)); const int lane = tid & 63, wave = __builtin_amdgcn_readfirstlane(tid >> 6); \
    const int vcu = (G % 8 == 0) ? (bx % 8) * (G / 8) + bx / 8 : bx; const int gw = vcu * NWAVES + wave, NGW = G * NWAVES; (void)lane; (void)gw; (void)NGW
    for (int u = threadIdx.x; u < 64; u += NWAVES * 64) ((LAS unsigned*)(lds + MISC_OFF))[u] = 0u;
    if (threadIdx.x == 0) { LAS unsigned long long* TAB = (LAS unsigned long long*)(lds + TAB_OFF);
#pragma unroll
        for (int i = 0; i < 30; ++i) TAB[i] = (unsigned long long)args.in[i];
        TAB[30] = (unsigned long long)args.out; TAB[31] = (unsigned long long)args.ws; }
    __syncthreads();
#if !MK_PER_PHASE
    (void)xcd_barrier_post((GAS unsigned*)(args.ws + WS_CTL) + CW_BAR, MISC + 8, threadIdx.x == 0);
#define GRID_BAR() do { XcdBarrier b_; const unsigned long long bp_ = tab_ld(lds, 31) + WS_CTL + 4ull * CW_BAR; unsigned blo_ = (unsigned)bp_, bhi_ = (unsigned)(bp_ >> 32); unsigned x_ = __builtin_amdgcn_readfirstlane(xb_xcc_id()), st_ = __builtin_amdgcn_readfirstlane((unsigned)(size_t)(LAS unsigned*)(lds + MISC_OFF + 32)); asm volatile("" : "+s"(blo_), "+s"(bhi_), "+s"(x_), "+s"(st_)); b_.bar = (GAS unsigned*)(((unsigned long long)bhi_ << 32) | blo_); b_.x = x_; b_.st = (volatile LAS unsigned*)(size_t)st_; xcd_barrier(b_, wave_s == 0 && pg8::lane_id() == 0); } while (0)
#else
#define GRID_BAR() do {} while (0)
#endif
    const int lo = args.ph_lo, hi = args.ph_hi;
#define IN(k) (lo <= (k) && (k) < hi)
#define SEAM(k) do { if (IN(k) && IN((k) + 1)) GRID_BAR(); } while (0)

    if (PHT(16) && IN(0)) { PHASE_IDS();
        const gu8 ws = TWS();
        LAS float* scr = (LAS float*)(lds + wave * 16384);
        constexpr int I_FIN = (DM / 64) * (2 * DFF / 32), I_FDN = (DFF / 64) * (DM / 32), I_WIN = (DM / 64) * (4096 / 32), I_SQ = (DM / 64) * (DM / 32), I_LR = 8 * 2 * 4;
        constexpr int I_LAYER = 2 * I_FIN + 2 * I_FDN + 2 * I_WIN + 3 * I_SQ + 2 * I_LR;
        for (int it = gw; it < DEPTH * I_LAYER; it += NGW) {
            const int l = it / I_LAYER; int r = it - l * I_LAYER;
            const gu8 wl = ws + WS_W + (size_t)l * WL_SIZE;
            if (r < I_FIN) { p0_mat_ffn_in(TIN(8) + (size_t)l * DM * 2 * DFF, (gb)(wl + WL_FIN1), r, scr, lane, TIN(7) + ((size_t)l * 2 + 0) * DM); continue; } r -= I_FIN;
            if (r < I_FIN) { p0_mat_ffn_in(TIN(28) + (size_t)l * DM * 2 * DFF, (gb)(wl + WL_FIN2), r, scr, lane, TIN(27) + ((size_t)l * 2 + 0) * DM); continue; } r -= I_FIN;
            if (r < I_FDN) { p0_mat(TIN(9) + (size_t)l * DFF * DM, DFF, DM, (gb)(wl + WL_FDN1), r, scr, lane); continue; } r -= I_FDN;
            if (r < I_FDN) { p0_mat(TIN(29) + (size_t)l * DFF * DM, DFF, DM, (gb)(wl + WL_FDN2), r, scr, lane); continue; } r -= I_FDN;
            if (r < I_WIN) { p0_mat(TIN(11) + (size_t)l * DM * 4096, DM, 4096, (gb)(wl + WL_WIN), r, scr, lane, TIN(10) + ((size_t)l * 2 + 0) * DM); continue; } r -= I_WIN;
            if (r < I_WIN) { p0_mat(TIN(25) + (size_t)l * DM * 4096, DM, 4096, (gb)(wl + WL_WKV), r, scr, lane); continue; } r -= I_WIN;
            if (r < I_SQ) { p0_mat(TIN(22) + (size_t)l * DM * DM, DM, DM, (gb)(wl + WL_WOUT), r, scr, lane); continue; } r -= I_SQ;
            if (r < I_SQ) { p0_mat(TIN(24) + (size_t)l * DM * DM, DM, DM, (gb)(wl + WL_WQ), r, scr, lane, TIN(23) + ((size_t)l * 3 + 0) * DM); continue; } r -= I_SQ;
            if (r < I_SQ) { p0_mat(TIN(26) + (size_t)l * DM * DM, DM, DM, (gb)(wl + WL_WO), r, scr, lane); continue; } r -= I_SQ;
            if (r < I_LR) { const int hh = r >> 3; p0_mat(TIN(14) + ((size_t)l * 8 + hh) * 16384, 128, 128, (gb)(wl + WL_LRA) + (size_t)hh * 16384, r & 7, scr, lane); continue; } r -= I_LR;
            { const int hh = r >> 3; p0_mat(TIN(16) + ((size_t)l * 8 + hh) * 16384, 128, 128, (gb)(wl + WL_LRI) + (size_t)hh * 16384, r & 7, scr, lane); }
        }
        { const cgf sgw = TIN(20);
        for (int i = gw * 64 + lane; i < DEPTH * 8 * 128 * 128 / 4; i += NGW * 64) { const int e = i * 4; const int l = e >> 17, rem = e & 131071, t = (rem >> 7) & 127, s0 = rem & 127;
            const f32x4 w = *(const GAS f32x4*)(sgw + e);
            v2u o; o.x = pk2(s0 <= t ? w.x : 0.f, s0 + 1 <= t ? w.y : 0.f); o.y = pk2(s0 + 2 <= t ? w.z : 0.f, s0 + 3 <= t ? w.w : 0.f);
            *(GAS v2u*)((gb)(ws + WS_W + (size_t)l * WL_SIZE + WL_SGW) + rem) = o; } }
        { const cgf mem = TIN(2); const cgf xan = TIN(23);
        for (int m = gw; m < DEPTH * MMEM; m += NGW) { const int l = m / MMEM, r = m % MMEM; rms_row_to_bf16(mem + (size_t)r * DM, xan + ((size_t)l * 3 + 2) * DM, (gb)(ws + WS_MEMN) + (size_t)m * DM, lane); } }
        { const cgf xp = TIN(0); const cgf xs = TIN(1);
        for (int m = gw; m < MT; m += NGW) { const cgf xr = (m < MP) ? xp + (size_t)m * DM : xs + (size_t)(m - MP) * DM; x_row_init(xr, (gb)(ws + WS_HB) + (size_t)m * DM, (gf)(ws + WS_RS) + (size_t)m * 8, lane); } }
    }
    SEAM(0);

    for (int l = 0; l < DEPTH; ++l) {
        const int pb = 1 + 16 * l;
#define FFN_IN_PHASE(ph, WOFF, WITHKV) if (PHT(0) && IN(ph)) { const gu8 ws = TWS(); const gf out = TOUT(); \
            SchedFfnIn S{(cgc)(ws + WS_HB), (cgc)(ws + WS_W + (size_t)l * WL_SIZE + (WOFF)), (cgc)(ws + WS_MEMN + (size_t)l * MMEM * DM * 2), (cgc)(ws + WS_W + (size_t)l * WL_SIZE + WL_WKV), G, bx, (WITHKV)}; \
            pg8::EpiFfnIn E{(gb)(ws + WS_ACT), DFF, out + OUT_MK + (size_t)l * MMEM * DM, (gb)(ws + WS_KB), out + OUT_MV + (size_t)l * MMEM * DM, (gb)(ws + WS_VT), (cgf)(ws + WS_RS)}; \
            pg8::gemm_phase<pg8::EpiFfnIn, SchedFfnIn, true, true, false, true>(lds, wave_s, DM, DM, S, E); } SEAM(ph);
#define TG_PHASE(ph, PHT_ID, AOFF, WOFF, KK, KINST, G1, CC) if (PHT(PHT_ID) && IN(ph)) { const gu8 ws = TWS(); const int inst = l * 4 + (KINST); \
            SchedStrip<false> S{(cgc)(ws + (AOFF)), (cgc)(ws + WS_W + (size_t)l * WL_SIZE + (WOFF)), (KK), (KK), DM / 256, (KK), G, bx}; \
            pg8::EpiT E{TIN(0), TIN(1), (gb)(ws + WS_HB), TOUT(), (G1), (CC), (gf)(ws + WS_TXB) + (size_t)inst * 32 * 272 * 8, (GAS unsigned*)(ws + WS_CTL) + CW_TC + inst * 512, (gf)(ws + WS_RS), \
                        (inst == 0) ? 1 : ((inst == 4 * DEPTH - 1) ? 2 : 0)}; \
            pg8::gemm_phase<pg8::EpiT, SchedStrip<false>, false, true, true, KOUT_T>(lds, wave_s, (KK), (KK), S, E); } SEAM(ph);
        FFN_IN_PHASE(pb + 0, WL_FIN1, 1)
        TG_PHASE(pb + 1, 1, WS_ACT, WL_FDN1, DFF, 0, TIN(7) + ((size_t)l * 2 + 1) * DM, 0.5f)

        if (PHT(3) && IN(pb + 3)) { const gu8 ws = TWS();
            SchedStrip<true> S{(cgc)(ws + WS_HB), (cgc)(ws + WS_W + (size_t)l * WL_SIZE + WL_WIN), DM, DM, 16, DM, G, bx};
            pg8::EpiMixIn E{(gf)(ws + WS_XL), (gb)(ws + WS_GL), (gb)(ws + WS_UG), (gf)(ws + WS_VG), (gf)(ws + WS_VST), (gf)(ws + WS_SLAB), (cgf)(ws + WS_RS)};
            pg8::gemm_phase<pg8::EpiMixIn, SchedStrip<true>, true, true, true, KOUT_M>(lds, wave_s, DM, DM, S, E);
        }
        SEAM(pb + 3);

        if (PHT(4) && IN(pb + 4)) { PHASE_IDS();
            constexpr int NU_LP = NB * 16 * 8, NU_LS = (MS / 128) * 8, NU_SG = NB * 16 * 8;
            for (int u = bx; u < NU_LP; u += G) lru_unit<false>(lds, l, u, tid, wave, lane);
            {
                gu32* qc = (gu32*)(TWS() + WS_CTL) + CW_QC + l * 64;
                for (;;) {
                    if (tid == 0) MISC[16] = __hip_atomic_fetch_add(qc, 1u, RLX_AGENT);
                    __syncthreads(); const int it = __builtin_amdgcn_readfirstlane((int)MISC[16]); __syncthreads();
                    if (it >= NU_LS + NU_SG) break;
                    if (it < NU_LS) lru_unit<true>(lds, l, it, tid, wave, lane); else sgu_unit(lds, l, it - NU_LS, tid, wave, lane);
                }
            }
            for (int nb = gw; nb < DECB; nb += NGW) sgu_sample_item(lds, l, nb, lane);
        }
        SEAM(pb + 4);

        TG_PHASE(pb + 6, 6, WS_YMIX, WL_WOUT, DM, 1, TIN(10) + ((size_t)l * 2 + 1) * DM, 1.0f)

        if (PHT(8) && IN(pb + 8)) { const gu8 ws = TWS();
            SchedStrip<false> S{(cgc)(ws + WS_HB), (cgc)(ws + WS_W + (size_t)l * WL_SIZE + WL_WQ), DM, DM, DM / 256, DM, G, bx};
            pg8::EpiQ E{(gb)(ws + WS_QB), (gf)(ws + WS_SLAB), (cgf)(ws + WS_RS), MP};
            pg8::gemm_phase<pg8::EpiQ, SchedStrip<false>, true, true, true, KOUT_Q>(lds, wave_s, DM, DM, S, E);
        }
        SEAM(pb + 8);

        const bool fuse_pv = (G >= NB * XAH * 8 * 2);
        if (PHT(9) && IN(pb + 9)) {
            gu32* xf = (gu32*)(TWS() + WS_CTL) + CW_XF + l * (NB * XAH * 8) * 16;
            { const gu8 ws = TWS();
            SchedX1 S{(cgc)(ws + WS_QB), (cgc)(ws + WS_KB), G, bx};
            pg8::EpiSoftmax E{(gb)(ws + WS_PB), 1024, 0.04419417382f * 1.44269504089f};
            pg8::gemm_phase<pg8::EpiSoftmax, SchedX1, false, true>(lds, wave_s, DM, DM, S, E); }
            VM_WAIT(); __syncthreads(); PHASE_IDS();
            if (fuse_pv && bx < NB * XAH * 8 && tid == 0) {
                __builtin_amdgcn_fence(__ATOMIC_RELEASE, "agent"); VM_WAIT();
                __hip_atomic_store(xf + 16 * bx, 1u, RLX_AGENT); }
            for (int u = bx; u < DECB * XAH; u += G) sattn_unit(lds, l, u, tid, wave, lane);
            if (fuse_pv && bx >= NB * XAH * 8 && bx < NB * XAH * 8 * 2) {
                const int cc = bx - NB * XAH * 8;
                if (wave == 0) { unsigned spins = 0;
                    while ((unsigned)__builtin_amdgcn_readfirstlane((int)__hip_atomic_load(xf + 16 * cc, RLX_AGENT)) == 0u) { __builtin_amdgcn_s_sleep(1); if (++spins > (1u << 20)) break; }
                    __builtin_amdgcn_fence(__ATOMIC_ACQUIRE, "agent"); VM_WAIT(); }
                __syncthreads();
                const gu8 ws = TWS();
                SchedX2pair S{(cgc)(ws + WS_PB), (cgc)(ws + WS_VT), cc};
                pg8::EpiBf16 E{(gb)(ws + WS_OB), DM};
                pg8::gemm_phase<pg8::EpiBf16, SchedX2pair, true, true>(lds, wave_s, 1024, 1024, S, E);
            }
        }
        SEAM(pb + 9);

        if (!fuse_pv) {
        if (PHT(10) && IN(pb + 10)) { const gu8 ws = TWS();
            SchedX2 S{(cgc)(ws + WS_PB), (cgc)(ws + WS_VT), G, bx};
            pg8::EpiBf16 E{(gb)(ws + WS_OB), DM};
            pg8::gemm_phase<pg8::EpiBf16, SchedX2, true, true>(lds, wave_s, 1024, 1024, S, E);
        }
        SEAM(pb + 10);
        }

        TG_PHASE(pb + 11, 6, WS_OB, WL_WO, DM, 2, TIN(23) + ((size_t)l * 3 + 1) * DM, 1.0f)
        FFN_IN_PHASE(pb + 13, WL_FIN2, 0)
        TG_PHASE(pb + 14, 1, WS_ACT, WL_FDN2, DFF, 3, TIN(27) + ((size_t)l * 2 + 1) * DM, 0.5f)
    }
#undef IN
#undef SEAM
}

extern "C" void kernel_launch(void* const* d_in, const int* in_sizes, int n_in, void* d_out, int out_size, void* d_ws, size_t ws_size, hipStream_t stream) {
    static int grid = 0;
    if (grid == 0) {
        if (n_in != 30 || (size_t)out_size != OUT_END || ws_size < WS_END) { fprintf(stderr, "kernel_launch: built for 30 inputs, %zu outputs, >= %zu bytes of workspace; got n_in %d, out %d, ws %zu; nothing launched\n", (size_t)OUT_END, (size_t)WS_END, n_in, out_size, ws_size); grid = -1; return; }
        int dev = 0, cus = 0, per_cu = 0;
        if (hipGetDevice(&dev) != hipSuccess || hipDeviceGetAttribute(&cus, hipDeviceAttributeMultiprocessorCount, dev) != hipSuccess) { fprintf(stderr, "kernel_launch: device query failed\n"); grid = -1; return; }
        if (hipFuncSetAttribute((const void*)fwd, hipFuncAttributeMaxDynamicSharedMemorySize, LDS_BYTES) != hipSuccess) { fprintf(stderr, "kernel_launch: hipFuncSetAttribute failed\n"); grid = -1; return; }
        if (hipOccupancyMaxActiveBlocksPerMultiprocessor(&per_cu, (const void*)fwd, NWAVES * 64, LDS_BYTES) != hipSuccess || per_cu < 1) { fprintf(stderr, "kernel_launch: occupancy query reports %d\n", per_cu); }
        (void)hipGetLastError();
        grid = cus;
    }
    if (grid < 0) return;
    if (hipMemsetAsync((char*)d_ws + WS_CTL, 0, CTL_ZERO_BYTES, stream) != hipSuccess) { fprintf(stderr, "kernel_launch: memset failed\n"); return; }
    Args a{};
    for (int i = 0; i < 30; ++i) a.in[i] = (const float*)d_in[i];
    a.out = (float*)d_out; a.ws = (unsigned char*)d_ws;
#if MK_PER_PHASE
    for (int p = 0; p < NPHASES; ++p) { a.ph_lo = p; a.ph_hi = p + 1; hipLaunchKernelGGL(fwd, dim3(grid), dim3(NWAVES * 64), LDS_BYTES, stream, a); }
#else
    a.ph_lo = 0; a.ph_hi = NPHASES - 1;
    hipLaunchKernelGGL(fwd, dim3(grid), dim3(NWAVES * 64), LDS_BYTES, stream, a);
#endif
    const hipError_t le = hipPeekAtLastError();
    if (le != hipSuccess) fprintf(stderr, "kernel_launch: launch failed: %s\n", hipGetErrorName(le));
}
```

```cpp
#include <hip/hip_runtime.h>
#include <cstdio>
#include <cstdint>

#ifndef KOUT_T
#define KOUT_T true
#endif
#ifndef KOUT_Q
#define KOUT_Q true
#endif
#ifndef KOUT_M
#define KOUT_M true
#endif
#ifndef PH_ONLY
#define PH_ONLY (-1)
#endif
#define PHT(j) (PH_ONLY < 0 || PH_ONLY == (j))
#ifndef MK_PER_PHASE
#define MK_PER_PHASE 0
#endif

namespace pg8 {
#define PG8_LAS __attribute__((address_space(3)))
typedef unsigned short bf16_t;
typedef short bf16x8 __attribute__((ext_vector_type(8)));
typedef float f32x4 __attribute__((ext_vector_type(4)));
typedef float f32x2 __attribute__((ext_vector_type(2)));
typedef unsigned u32x4 __attribute__((ext_vector_type(4)));
typedef unsigned u32x2 __attribute__((ext_vector_type(2)));
constexpr int KIND_SLAB = 8;
constexpr int BM = 256, BK = 64, HALF = 128, HTB = HALF * BK * 2  , STAGE_BYTES = 8 * HTB, NXCD = 8, WGM = 4;

__host__ __device__ __forceinline__ int lds_byte(int r, int c) { const int st = (r >> 4) * 2 + (c >> 5), rr = r & 15, cc = c & 31, ob = rr * 64 + cc * 2; return st * 1024 + (ob ^ (((ob >> 9) & 1) << 5)); }
__host__ __device__ __forceinline__ void stage_rc(int b, int& R, int& C) { const int st = b / 1024, sb = b % 1024, swz = sb ^ (((sb >> 9) & 1) << 5); R = (st >> 1) * 16 + swz / 64; C = (st & 1) * 32 + (swz % 64) / 2; }
__host__ __device__ __forceinline__ int perm32(int rho) { const int n = rho >> 4, i = rho & 15; return 8 * (i >> 2) + 4 * n + (i & 3); }

#define PG8_GAS __attribute__((address_space(1)))
__device__ __forceinline__ int lane_id() { unsigned z = 0u; asm volatile("" : "+v"(z)); return (int)__builtin_amdgcn_mbcnt_hi(~0u, __builtin_amdgcn_mbcnt_lo(~0u, z)); }
__device__ __forceinline__ float shx(float v, int m) {
    const int iv = __float_as_int(v); int r;
    switch (m) {
        case 1:  r = __builtin_amdgcn_ds_swizzle(iv, 0x041F); break;
        case 2:  r = __builtin_amdgcn_ds_swizzle(iv, 0x081F); break;
        case 4:  r = __builtin_amdgcn_ds_swizzle(iv, 0x101F); break;
        case 8:  r = __builtin_amdgcn_ds_swizzle(iv, 0x201F); break;
        case 16: r = __builtin_amdgcn_ds_swizzle(iv, 0x401F); break;
        default: r = __builtin_amdgcn_ds_bpermute((lane_id() ^ 32) << 2, iv); break;
    }
    return __int_as_float(r);
}
__device__ __forceinline__ float rs_of(const __attribute__((address_space(1))) float* SSQ, int row) {
    typedef float f4 __attribute__((ext_vector_type(4)));
    const f4 a = *(const __attribute__((address_space(1))) f4*)(SSQ + (size_t)row * 8), b = *(const __attribute__((address_space(1))) f4*)(SSQ + (size_t)row * 8 + 4);
    return __builtin_amdgcn_rsqf((((a[0] + a[1]) + (a[2] + a[3])) + ((b[0] + b[1]) + (b[2] + b[3]))) * (1.0f / 2048.0f) + 1e-6f);
}
__device__ __forceinline__ void rs8_of(const __attribute__((address_space(1))) float* SSQ, int row0, float (&r)[2][4]) {
    typedef float f4 __attribute__((ext_vector_type(4)));
    f4 a[2][4], b[2][4];
#pragma unroll
    for (int ai = 0; ai < 2; ++ai)
#pragma unroll
        for (int m = 0; m < 4; ++m) { const __attribute__((address_space(1))) f4* p = (const __attribute__((address_space(1))) f4*)(SSQ + (size_t)(row0 + ai * 128 + m * 16) * 8); a[ai][m] = p[0]; b[ai][m] = p[1]; }
#pragma unroll
    for (int ai = 0; ai < 2; ++ai)
#pragma unroll
        for (int m = 0; m < 4; ++m) { r[ai][m] = __builtin_amdgcn_rsqf((((a[ai][m][0] + a[ai][m][1]) + (a[ai][m][2] + a[ai][m][3])) + ((b[ai][m][0] + b[ai][m][1]) + (b[ai][m][2] + b[ai][m][3]))) * (1.0f / 2048.0f) + 1e-6f);
            asm volatile("" : "+v"(r[ai][m])); }
}
struct GUnit { const PG8_GAS char* a; const PG8_GAS char* b; int sd; int orow, ocol, kind, nt, srow; };

__device__ __forceinline__ void tile_of(int wgid, int nM, int nN, int& pm, int& pn) {
    const int nwg = nM * nN;
    { const int q = nwg / NXCD, r = nwg % NXCD, xcd = wgid % NXCD, off = wgid / NXCD; wgid = (xcd < r ? xcd * (q + 1) : r * (q + 1) + (xcd - r) * q) + off; }
    const int nig = WGM * nN, gid = wgid / nig, fm = gid * WGM, gsz = (nM - fm) < WGM ? (nM - fm) : WGM;
    pm = fm + ((wgid % nig) % gsz); pn = (wgid % nig) / gsz;
}

__device__ __forceinline__ unsigned cvt_pk_bf16(float lo, float hi) { unsigned r; asm volatile("v_cvt_pk_bf16_f32 %0, %1, %2" : "=v"(r) : "v"(lo), "v"(hi)); return r; }
__device__ __forceinline__ float fast_sigmoid(float x) { return __builtin_amdgcn_rcpf(1.0f + __builtin_amdgcn_exp2f(-1.44269504089f * x)); }
__device__ __forceinline__ float silu_f(float x) { return x * fast_sigmoid(x); }
typedef float f32x2 __attribute__((ext_vector_type(2)));
__device__ __forceinline__ unsigned swiglu2_pk(float ga, float gb, float ua, float ub) {
    const f32x2 g = {ga, gb}, u = {ua, ub};
    const f32x2 t = g * -1.44269504089f;
    f32x2 e = {__builtin_amdgcn_exp2f(t.x), __builtin_amdgcn_exp2f(t.y)};
    e = e + 1.0f;
    const f32x2 r = {__builtin_amdgcn_rcpf(e.x), __builtin_amdgcn_rcpf(e.y)};
    const f32x2 h = (g * u) * r;
    return cvt_pk_bf16(h.x, h.y);
}
__device__ __forceinline__ float gelu_f(float x) { const float t = x * (1.0f + 0.044715f * x * x); return x * __builtin_amdgcn_rcpf(1.0f + __builtin_amdgcn_exp2f(-2.30220819814f * t)); }

template <class Epi, class Sched, bool ALIGN_EPI, bool SP2, bool STRIP = false, bool KOUT = true>
__device__ __forceinline__ void gemm_phase(PG8_LAS unsigned char* lds, const int wave_s, const int lda_, const int ldb_, const Sched& S, const Epi& E) {
    int lda = lda_, ldb = ldb_;
    asm volatile("" : "+s"(lda), "+s"(ldb));
    int tid = wave_s * 64 + lane_id(); asm volatile("" : "+v"(tid));
    const int wid = __builtin_amdgcn_readfirstlane(tid >> 6), lane = tid & 63, wr = wid >> 2, wc = wid & 3, fr = lane & 15, fq = lane >> 4;
    unsigned voffA, voffB;
    { int R, C; stage_rc(tid * 16, R, C); const int Rb = Epi::PERM ? ((R & ~31) + perm32(R & 31)) : R;
        voffA = (unsigned)(R * lda + C) * 2u; voffB = (unsigned)(Rb * ldb + C) * 2u; }
    const size_t r64A = (size_t)64 * lda * 2, r64B = (size_t)64 * ldb * 2;
    const size_t kstep = (size_t)(BK * 2);
    const size_t hstepA = (size_t)HALF * lda * 2, hstepB = (size_t)HALF * ldb * 2;
    const unsigned ldsw = (unsigned)wid * 1024u;
    const int aoff = lds_byte(wr * 64 + fr, fq * 8), boff = lds_byte(wc * 32 + fr, fq * 8);
    const bool s_act = STRIP && lane < 16;
    unsigned vs_s = 0; int so_s = 0;
    if constexpr (STRIP) { const int c_ = wid * 16 + (lane & 15), r_ = c_ >> 3, g_ = (c_ & 7) ^ ((r_ >> 1) & 7); vs_s = (unsigned)(r_ * lda) * 2u + (unsigned)(g_ * 16);
        so_s = fr * 128 + ((fq ^ ((fr >> 1) & 7)) * 16); }
    PG8_LAS unsigned char* ldsB = lds + 65536 + boff; asm volatile("" : "+v"(ldsB));
    PG8_LAS unsigned char* ldsS0 = lds + STAGE_BYTES + so_s; PG8_LAS unsigned char* ldsS1 = lds + STAGE_BYTES + (so_s ^ 64);
    unsigned sm0_s = (unsigned)__builtin_amdgcn_readfirstlane((int)(unsigned)(size_t)(lds + STAGE_BYTES + wid * 256));
    if constexpr (STRIP) { asm volatile("" : "+v"(ldsS0), "+v"(ldsS1), "+s"(sm0_s)); }
    static_assert(!STRIP || SP2, "the strip rides on the SP2 loop");
#define PG8_SA(b, h) (((b) * 2 + (h)) * HTB)
#define PG8_SB(b, h) ((4 + (b) * 2 + (h)) * HTB)
#define PG8_STAGE(bufoff, gbase, voff) do { asm volatile("" : "+v"(voff)); const unsigned vo_ = (voff);     \
        _Pragma("unroll") for (int _i = 0; _i < 2; ++_i) { const PG8_GAS char* gb_ = (gbase) + (size_t)_i * r64_##voff; asm volatile("" : "+s"(gb_));     \
        __builtin_amdgcn_global_load_lds((const PG8_GAS unsigned*)(gb_ + vo_), (PG8_LAS unsigned*)(lds + (bufoff) + ldsw + _i * 8192), 16, 0, 0); } } while (0)
#define r64_voffA r64A
#define r64_voffB r64B
#define PG8_LDA(dst, b, h) do { _Pragma("unroll") for (int m = 0; m < 4; ++m) _Pragma("unroll") for (int k = 0; k < 2; ++k) dst[m][k] = *(const PG8_LAS bf16x8*)(lds + PG8_SA(b, h) + aoff + m * 2048 + k * 1024); } while (0)
#define PG8_LDB(dst, b, h) do { _Pragma("unroll") for (int n = 0; n < 2; ++n) _Pragma("unroll") for (int k = 0; k < 2; ++k) dst[n][k] = *(const PG8_LAS bf16x8*)(ldsB + (PG8_SB(b, h) - 65536) + n * 2048 + k * 1024); } while (0)
#define PG8_MMA(ai, bj, At, Bt) do { __builtin_amdgcn_s_setprio(1); \
        if constexpr (KOUT) { _Pragma("unroll") for (int k = 0; k < 2; ++k) _Pragma("unroll") for (int m = 0; m < 4; ++m) _Pragma("unroll") for (int n_ = 0; n_ < 2; ++n_) { const int n = ((m ^ k) & 1) ? 1 - n_ : n_;     \
            acc[ai][bj][m][n] = __builtin_amdgcn_mfma_f32_16x16x32_bf16(Bt[n][k], At[m][k], acc[ai][bj][m][n], 0, 0, 0); } } \
        else { _Pragma("unroll") for (int m = 0; m < 4; ++m) _Pragma("unroll") for (int n = 0; n < 2; ++n) _Pragma("unroll") for (int k = 0; k < 2; ++k) \
            acc[ai][bj][m][n] = __builtin_amdgcn_mfma_f32_16x16x32_bf16(Bt[n][k], At[m][k], acc[ai][bj][m][n], 0, 0, 0); } \
        __builtin_amdgcn_s_setprio(0); } while (0)
#define PG8_SS(b) (STAGE_BYTES + (b) * 2048)
#define PG8_STAGE_S(b, gbase) do { if constexpr (STRIP) { \
        if (s_act) {        \
            const PG8_GAS char* gs_ = (gbase); asm volatile("" : "+v"(vs_s), "+s"(gs_)); const unsigned vs_ = vs_s; \
            __builtin_amdgcn_global_load_lds((const PG8_GAS unsigned*)(gs_ + vs_), (PG8_LAS unsigned*)(size_t)(sm0_s + (b) * 2048), 16, 0, 0); } } } while (0)
#define PG8_LDS_S(b) do { if constexpr (STRIP) { \
        As[0] = *(const PG8_LAS bf16x8*)(ldsS0 + (b) * 2048); As[1] = *(const PG8_LAS bf16x8*)(ldsS1 + (b) * 2048); } } while (0)
#define PG8_MMA_S() do { if constexpr (STRIP) { if (wr) { _Pragma("unroll") for (int k = 0; k < 2; ++k) { acc_s[0] = __builtin_amdgcn_mfma_f32_16x16x32_bf16(B0[1][k], As[k], acc_s[0], 0, 0, 0); acc_s[1] = __builtin_amdgcn_mfma_f32_16x16x32_bf16(B1[1][k], As[k], acc_s[1], 0, 0, 0); } } \
        else { _Pragma("unroll") for (int k = 0; k < 2; ++k) { acc_s[0] = __builtin_amdgcn_mfma_f32_16x16x32_bf16(B0[0][k], As[k], acc_s[0], 0, 0, 0); acc_s[1] = __builtin_amdgcn_mfma_f32_16x16x32_bf16(B1[0][k], As[k], acc_s[1], 0, 0, 0); } } } } while (0)
#define PG8_WAIT_V(n) asm volatile("s_waitcnt vmcnt(" #n ")" ::: "memory")
#define PG8_WAIT_VS(n, ns) do { if constexpr (STRIP) PG8_WAIT_V(ns); else PG8_WAIT_V(n); } while (0)
#define PG8_WAIT_L(n) asm volatile("s_waitcnt lgkmcnt(" #n ")" ::: "memory")
#define PG8_BAR __builtin_amdgcn_s_barrier()
#define PG8_SCHED __builtin_amdgcn_sched_barrier(0)
    GUnit cur, nxt; int ui = 0;
    if (!S.next(0, cur)) return;
    f32x4 acc[2][2][4][2];
#pragma unroll
    for (int a = 0; a < 2; ++a)
#pragma unroll
        for (int b = 0; b < 2; ++b)
#pragma unroll
            for (int m = 0; m < 4; ++m)
#pragma unroll
                for (int n = 0; n < 2; ++n) acc[a][b][m][n] = (f32x4){0.f, 0.f, 0.f, 0.f};
    bf16x8 At[4][2], B0[2][2], B1[2][2];
    bf16x8 As[2]; f32x4 acc_s[2]; acc_s[0] = (f32x4){0.f, 0.f, 0.f, 0.f}; acc_s[1] = (f32x4){0.f, 0.f, 0.f, 0.f};
    const PG8_GAS char* cA = cur.a; const PG8_GAS char* cB = cur.b; int cSd = cur.sd;
    if constexpr (SP2) {
        PG8_STAGE(PG8_SB(0, 0), cB, voffB); PG8_STAGE(PG8_SB(0, 1), cB + hstepB, voffB); PG8_STAGE(PG8_SA(0, 0), cA, voffA); PG8_STAGE_S(0, cA + cSd); PG8_STAGE(PG8_SA(0, 1), cA + hstepA, voffA);
        if (wr == 1) PG8_BAR;
        PG8_WAIT_V(2); PG8_BAR;
        PG8_STAGE(PG8_SB(1, 0), cB + kstep, voffB); PG8_STAGE(PG8_SA(1, 0), cA + kstep, voffA); PG8_STAGE(PG8_SB(1, 1), cB + hstepB + kstep, voffB); PG8_STAGE_S(1, cA + kstep + cSd);
        PG8_WAIT_VS(6, 7); PG8_BAR;
    } else {
        PG8_STAGE(PG8_SB(0, 0), cB, voffB); PG8_STAGE(PG8_SA(0, 0), cA, voffA); PG8_STAGE(PG8_SB(0, 1), cB + hstepB, voffB); PG8_STAGE(PG8_SA(0, 1), cA + hstepA, voffA);
        if (wr == 1) PG8_BAR;
        PG8_WAIT_V(4); PG8_BAR;
        PG8_STAGE(PG8_SB(1, 0), cB + kstep, voffB); PG8_STAGE(PG8_SA(1, 0), cA + kstep, voffA); PG8_STAGE(PG8_SB(1, 1), cB + hstepB + kstep, voffB);
        PG8_WAIT_V(6); PG8_BAR;
    }
    for (;;) {
        const bool has_next = S.next(ui + 1, nxt);
        int nt = cur.nt; asm volatile("" : "+s"(nt));
        const PG8_GAS char* nA = has_next ? nxt.a : cA; const PG8_GAS char* nB = has_next ? nxt.b : cB; const int nSd = has_next ? nxt.sd : cSd;
        for (int t = 0; t < nt; t += 2) {
            const bool last = (t == nt - 2);
            const PG8_GAS char* a1 = cA + (size_t)(t + 1) * kstep;
            const PG8_GAS char* a2 = last ? nA : cA + (size_t)(t + 2) * kstep; const PG8_GAS char* b2 = last ? nB : cB + (size_t)(t + 2) * kstep;
            const PG8_GAS char* a3 = a2 + kstep; const PG8_GAS char* b3 = b2 + kstep;
            const int sd2 = last ? nSd : cSd;
            if constexpr (SP2) {
            PG8_LDB(B0, 0, 0); PG8_LDB(B1, 0, 1); PG8_SCHED; PG8_LDA(At, 0, 0); PG8_LDS_S(0); PG8_STAGE(PG8_SA(1, 1), a1 + hstepA, voffA);
            PG8_WAIT_VS(8, 9); PG8_WAIT_L(0); PG8_BAR; PG8_MMA(0, 0, At, B0); PG8_MMA(0, 1, At, B1); PG8_MMA_S(); PG8_BAR; PG8_SCHED;
            PG8_LDA(At, 0, 1); PG8_STAGE(PG8_SB(0, 0), b2, voffB); PG8_STAGE(PG8_SB(0, 1), b2 + hstepB, voffB); PG8_STAGE(PG8_SA(0, 0), a2, voffA); PG8_STAGE_S(0, a2 + sd2);
            PG8_WAIT_VS(8, 9); PG8_WAIT_L(0); PG8_BAR; PG8_MMA(1, 0, At, B0); PG8_MMA(1, 1, At, B1); PG8_BAR; PG8_SCHED;
            PG8_LDB(B0, 1, 0); PG8_LDB(B1, 1, 1); PG8_SCHED; PG8_LDA(At, 1, 0); PG8_LDS_S(1); PG8_STAGE(PG8_SA(0, 1), a2 + hstepA, voffA);
            PG8_WAIT_VS(8, 9); PG8_WAIT_L(0); PG8_BAR; PG8_MMA(0, 0, At, B0); PG8_MMA(0, 1, At, B1); PG8_MMA_S(); PG8_BAR; PG8_SCHED;
            PG8_LDA(At, 1, 1); PG8_STAGE(PG8_SB(1, 0), b3, voffB); PG8_STAGE(PG8_SB(1, 1), b3 + hstepB, voffB); PG8_STAGE(PG8_SA(1, 0), a3, voffA); PG8_STAGE_S(1, a3 + sd2);
            PG8_WAIT_VS(8, 9); PG8_WAIT_L(0); PG8_BAR; PG8_MMA(1, 0, At, B0); PG8_MMA(1, 1, At, B1); PG8_BAR; PG8_SCHED;
            } else {
            PG8_LDB(B0, 0, 0); PG8_SCHED; PG8_LDA(At, 0, 0); PG8_STAGE(PG8_SA(1, 1), a1 + hstepA, voffA);
            PG8_WAIT_L(8); PG8_BAR; PG8_WAIT_L(0); PG8_MMA(0, 0, At, B0); PG8_BAR; PG8_SCHED;
            PG8_LDB(B1, 0, 1); PG8_STAGE(PG8_SB(0, 0), b2, voffB);
            PG8_BAR; PG8_WAIT_L(0); PG8_MMA(0, 1, At, B1); PG8_BAR;
            PG8_LDA(At, 0, 1); PG8_STAGE(PG8_SA(0, 0), a2, voffA);
            PG8_BAR; PG8_WAIT_L(0); PG8_MMA(1, 0, At, B0); PG8_BAR; PG8_SCHED;
            PG8_STAGE(PG8_SB(0, 1), b2 + hstepB, voffB);
            PG8_WAIT_V(6); PG8_BAR; PG8_MMA(1, 1, At, B1); PG8_BAR;
            PG8_LDB(B0, 1, 0); PG8_SCHED; PG8_LDA(At, 1, 0); PG8_STAGE(PG8_SA(0, 1), a2 + hstepA, voffA);
            PG8_WAIT_L(8); PG8_BAR; PG8_WAIT_L(0); PG8_MMA(0, 0, At, B0); PG8_BAR; PG8_SCHED;
            PG8_LDB(B1, 1, 1); PG8_STAGE(PG8_SB(1, 0), b3, voffB);
            PG8_BAR; PG8_WAIT_L(0); PG8_MMA(0, 1, At, B1); PG8_BAR;
            PG8_LDA(At, 1, 1); PG8_STAGE(PG8_SA(1, 0), a3, voffA);
            PG8_BAR; PG8_WAIT_L(0); PG8_MMA(1, 0, At, B0); PG8_BAR; PG8_SCHED;
            PG8_STAGE(PG8_SB(1, 1), b3 + hstepB, voffB);
            PG8_WAIT_V(6); PG8_BAR; PG8_MMA(1, 1, At, B1); PG8_BAR;
            }
        }
        if constexpr (ALIGN_EPI) { if (wr == 0) PG8_BAR; }
        if constexpr (!Epi::AFTER_DRAIN) { const int le_ = lane_id(), fre_ = le_ & 15, fqe_ = le_ >> 4;
            E(acc, cur, wr, wc, fre_, fqe_); if constexpr (STRIP) { E.strip(acc_s, cur, wr, wc, fre_, fqe_); acc_s[0] = (f32x4){0.f, 0.f, 0.f, 0.f}; acc_s[1] = (f32x4){0.f, 0.f, 0.f, 0.f}; } }
        if (!has_next) break;
#pragma unroll
        for (int a = 0; a < 2; ++a)
#pragma unroll
            for (int b = 0; b < 2; ++b)
#pragma unroll
                for (int m = 0; m < 4; ++m)
#pragma unroll
                    for (int n = 0; n < 2; ++n) acc[a][b][m][n] = (f32x4){0.f, 0.f, 0.f, 0.f};
        cur = nxt; cA = nA; cB = nB; cSd = nSd; ++ui;
        if constexpr (ALIGN_EPI) { if (wr == 1) PG8_BAR; }
    }
    PG8_WAIT_V(0);
    if constexpr (!ALIGN_EPI) { if (wr == 0) PG8_BAR; }
    PG8_BAR;
    if constexpr (Epi::AFTER_DRAIN) {
        int t2 = wave_s * 64 + lane_id(); asm volatile("" : "+v"(t2));
        const int wid2 = __builtin_amdgcn_readfirstlane(t2 >> 6), lane2 = t2 & 63;
        if constexpr (STRIP) E.fused(acc, acc_s, cur, wid2 >> 2, wid2 & 3, lane2 & 15, lane2 >> 4, lds, wid2, lane2); else E.fused(acc, cur, wid2 >> 2, wid2 & 3, lane2 & 15, lane2 >> 4, lds, wid2, lane2); }
#undef PG8_SA
#undef PG8_SB
#undef PG8_STAGE
#undef r64_voffA
#undef r64_voffB
#undef PG8_LDA
#undef PG8_LDB
#undef PG8_MMA
#undef PG8_WAIT_V
#undef PG8_WAIT_VS
#undef PG8_SS
#undef PG8_STAGE_S
#undef PG8_LDS_S
#undef PG8_MMA_S
#undef PG8_WAIT_L
#undef PG8_BAR
#undef PG8_SCHED
}

typedef f32x4 acc_t[2][2][4][2];

struct EpiD {
    static constexpr bool PERM = true, AFTER_DRAIN = false;
    PG8_GAS bf16_t* D; PG8_GAS float* SL;
    __device__ __forceinline__ void strip(const f32x4 (&as)[2], const GUnit& u, int wr, int wc, int fr, int fq) const {
        PG8_GAS bf16_t* rowp = D + (size_t)(u.srow + fr) * 2048 + u.ocol + wc * 32 + 8 * fq + 4 * wr;
#pragma unroll
        for (int bj = 0; bj < 2; ++bj) { u32x2 w; w.x = cvt_pk_bf16(as[bj][0], as[bj][1]); w.y = cvt_pk_bf16(as[bj][2], as[bj][3]); *(PG8_GAS u32x2*)(rowp + bj * HALF) = w; }
    }
    __device__ __forceinline__ void operator()(const acc_t& acc, const GUnit& u, int wr, int wc, int fr, int fq) const {
        const int row0 = u.orow + wr * 64 + fr, col0 = u.ocol + wc * 32 + 8 * fq;
        if (u.kind == KIND_SLAB) {
#pragma unroll
            for (int ai = 0; ai < 2; ++ai)
#pragma unroll
                for (int m = 0; m < 4; ++m) { PG8_GAS float* rowp = SL + (size_t)(row0 + ai * HALF + m * 16) * 2048 + col0;
#pragma unroll
                    for (int bj = 0; bj < 2; ++bj) { *(PG8_GAS f32x4*)(rowp + bj * HALF) = acc[ai][bj][m][0]; *(PG8_GAS f32x4*)(rowp + bj * HALF + 4) = acc[ai][bj][m][1]; } }
        } else {
#pragma unroll
            for (int ai = 0; ai < 2; ++ai)
#pragma unroll
                for (int m = 0; m < 4; ++m) { PG8_GAS bf16_t* rowp = D + (size_t)(row0 + ai * HALF + m * 16) * 2048 + col0;
#pragma unroll
                    for (int bj = 0; bj < 2; ++bj) { const f32x4 v0 = acc[ai][bj][m][0], v1 = acc[ai][bj][m][1];
                        u32x4 w; w.x = cvt_pk_bf16(v0[0], v0[1]); w.y = cvt_pk_bf16(v0[2], v0[3]); w.z = cvt_pk_bf16(v1[0], v1[1]); w.w = cvt_pk_bf16(v1[2], v1[3]);
                        *(PG8_GAS u32x4*)(rowp + bj * HALF) = w; } }
        }
    }
};
struct EpiFfnIn {
    static constexpr bool PERM = true, AFTER_DRAIN = false;
    PG8_GAS bf16_t* O; int ldo; PG8_GAS float* KF; PG8_GAS bf16_t* KB; PG8_GAS float* VF; PG8_GAS bf16_t* VT; const PG8_GAS float* RS;
    __device__ __forceinline__ void operator()(const acc_t& acc, const GUnit& u, int wr, int wc, int fr, int fq) const {
        const int row0 = u.orow + wr * 64 + fr, col0 = u.ocol + wc * 32 + 8 * fq;
        if (u.kind == 0) {
            float rsv[2][4]; rs8_of(RS, row0, rsv);
#pragma unroll
            for (int ai = 0; ai < 2; ++ai)
#pragma unroll
                for (int m = 0; m < 4; ++m) { PG8_GAS bf16_t* rowp = O + (size_t)(row0 + ai * HALF + m * 16) * ldo + col0; const float rs = rsv[ai][m];
                    const f32x4 g0 = acc[ai][0][m][0] * rs, g1 = acc[ai][0][m][1] * rs, u0 = acc[ai][1][m][0] * rs, u1 = acc[ai][1][m][1] * rs;
                    u32x4 w; w.x = swiglu2_pk(g0[0], g0[1], u0[0], u0[1]); w.y = swiglu2_pk(g0[2], g0[3], u0[2], u0[3]);
                    w.z = swiglu2_pk(g1[0], g1[1], u1[0], u1[1]); w.w = swiglu2_pk(g1[2], g1[3], u1[2], u1[3]);
                    *(PG8_GAS u32x4*)rowp = w; }
        } else if (u.kind == 1) {
#pragma unroll
            for (int ai = 0; ai < 2; ++ai)
#pragma unroll
                for (int m = 0; m < 4; ++m) { const size_t ro = (size_t)(row0 + ai * HALF + m * 16) * 2048 + col0;
#pragma unroll
                    for (int bj = 0; bj < 2; ++bj) { const f32x4 v0 = acc[ai][bj][m][0], v1 = acc[ai][bj][m][1];
                        *(PG8_GAS f32x4*)(KF + ro + bj * HALF) = v0; *(PG8_GAS f32x4*)(KF + ro + bj * HALF + 4) = v1;
                        u32x4 w; w.x = cvt_pk_bf16(v0[0], v0[1]); w.y = cvt_pk_bf16(v0[2], v0[3]); w.z = cvt_pk_bf16(v1[0], v1[1]); w.w = cvt_pk_bf16(v1[2], v1[3]);
                        *(PG8_GAS u32x4*)(KB + ro + bj * HALF) = w; } }
        } else {
#pragma unroll
            for (int ai = 0; ai < 2; ++ai)
#pragma unroll
                for (int m = 0; m < 4; ++m) { const int row = row0 + ai * HALF + m * 16;
#pragma unroll
                    for (int bj = 0; bj < 2; ++bj) { const f32x4 v0 = acc[ai][bj][m][0], v1 = acc[ai][bj][m][1];
                        u32x4 w; w.x = cvt_pk_bf16(v0[0], v0[1]); w.y = cvt_pk_bf16(v0[2], v0[3]); w.z = cvt_pk_bf16(v1[0], v1[1]); w.w = cvt_pk_bf16(v1[2], v1[3]);
                        *(PG8_GAS u32x4*)(VT + (size_t)row * 1024 + col0 + bj * HALF) = w;
                        PG8_GAS float* vp = VF + (size_t)(col0 + bj * HALF) * 2048 + row;
#pragma unroll
                        for (int j = 0; j < 4; ++j) { vp[(size_t)j * 2048] = v0[j]; vp[(size_t)(4 + j) * 2048] = v1[j]; } } }
        }
    }
};
struct EpiMixIn {
    static constexpr bool PERM = true, AFTER_DRAIN = false;
    PG8_GAS float* XL; PG8_GAS bf16_t* GL; PG8_GAS bf16_t* UG; PG8_GAS float* VG; PG8_GAS float* VST; PG8_GAS float* SL;
    const PG8_GAS float* RS;
    __device__ __forceinline__ void strip(const f32x4 (&as)[2], const GUnit& u, int wr, int wc, int fr, int fq) const {
        const int row = u.srow + fr, col = u.ocol + wc * 32 + 8 * fq + 4 * wr; const float rs = rs_of(RS, row);
#pragma unroll
        for (int bj = 0; bj < 2; ++bj) { const f32x4 v = as[bj] * rs;
            if (u.kind == 0) *(PG8_GAS f32x4*)(XL + (size_t)row * 1024 + col + bj * HALF) = v;
            else if (u.kind == 3) *(PG8_GAS f32x4*)(VG + (size_t)row * 1024 + col + bj * HALF) = (f32x4){gelu_f(v[0]), gelu_f(v[1]), gelu_f(v[2]), gelu_f(v[3])};
            else { u32x2 w; w.x = cvt_pk_bf16(gelu_f(v[0]), gelu_f(v[1])); w.y = cvt_pk_bf16(gelu_f(v[2]), gelu_f(v[3])); *(PG8_GAS u32x2*)(((u.kind == 1) ? GL : UG) + (size_t)row * 1024 + col + bj * HALF) = w; } }
    }
    __device__ __forceinline__ void operator()(const acc_t& acc, const GUnit& u, int wr, int wc, int fr, int fq) const {
        const int row0 = u.orow + wr * 64 + fr, col0 = u.ocol + wc * 32 + 8 * fq;
        float rsv[2][4]; rs8_of(RS, row0, rsv);
        if (u.kind == 0 || u.kind == KIND_SLAB) {
            PG8_GAS float* Fb = (u.kind == 0) ? XL : SL; const int ldf = (u.kind == 0) ? 1024 : 4096;
#pragma unroll
            for (int ai = 0; ai < 2; ++ai)
#pragma unroll
                for (int m = 0; m < 4; ++m) { PG8_GAS float* rowp = Fb + (size_t)(row0 + ai * HALF + m * 16) * ldf + col0; const float rs = rsv[ai][m];
#pragma unroll
                    for (int bj = 0; bj < 2; ++bj) { *(PG8_GAS f32x4*)(rowp + bj * HALF) = acc[ai][bj][m][0] * rs; *(PG8_GAS f32x4*)(rowp + bj * HALF + 4) = acc[ai][bj][m][1] * rs; } }
        } else if (u.kind == 3) {
#pragma unroll
            for (int ai = 0; ai < 2; ++ai)
#pragma unroll
                for (int m = 0; m < 4; ++m) { const int row = row0 + ai * HALF + m * 16; PG8_GAS float* rowp = VG + (size_t)row * 1024 + col0; float s = 0.f, q = 0.f; const float rs = rsv[ai][m];
#pragma unroll
                    for (int bj = 0; bj < 2; ++bj) { f32x4 v0 = acc[ai][bj][m][0] * rs, v1 = acc[ai][bj][m][1] * rs;
#pragma unroll
                        for (int j = 0; j < 4; ++j) { v0[j] = gelu_f(v0[j]); v1[j] = gelu_f(v1[j]); s += v0[j] + v1[j]; q += v0[j] * v0[j] + v1[j] * v1[j]; }
                        *(PG8_GAS f32x4*)(rowp + bj * HALF) = v0; *(PG8_GAS f32x4*)(rowp + bj * HALF + 4) = v1; }
                    s += pg8::shx(s, 16); s += pg8::shx(s, 32); q += pg8::shx(q, 16); q += pg8::shx(q, 32);
                    if (fq == 0) *(PG8_GAS f32x2*)(VST + ((size_t)row * 16 + (u.ocol >> 8) * 4 + wc) * 2) = (f32x2){s, q}; }
        } else {
            PG8_GAS bf16_t* O = (u.kind == 1) ? GL : UG;
#pragma unroll
            for (int ai = 0; ai < 2; ++ai)
#pragma unroll
                for (int m = 0; m < 4; ++m) { PG8_GAS bf16_t* rowp = O + (size_t)(row0 + ai * HALF + m * 16) * 1024 + col0; const float rs = rsv[ai][m];
#pragma unroll
                    for (int bj = 0; bj < 2; ++bj) { const f32x4 v0 = acc[ai][bj][m][0] * rs, v1 = acc[ai][bj][m][1] * rs;
                        u32x4 w; w.x = cvt_pk_bf16(gelu_f(v0[0]), gelu_f(v0[1])); w.y = cvt_pk_bf16(gelu_f(v0[2]), gelu_f(v0[3])); w.z = cvt_pk_bf16(gelu_f(v1[0]), gelu_f(v1[1])); w.w = cvt_pk_bf16(gelu_f(v1[2]), gelu_f(v1[3]));
                        *(PG8_GAS u32x4*)(rowp + bj * HALF) = w; } }
        }
    }
};
struct EpiQ {
    static constexpr bool PERM = true, AFTER_DRAIN = false;
    PG8_GAS bf16_t* Q; PG8_GAS float* SL; const PG8_GAS float* RS; int mp;
    __device__ __forceinline__ void strip(const f32x4 (&as)[2], const GUnit& u, int wr, int wc, int fr, int fq) const {
        const int row = u.srow + fr; const float rs = rs_of(RS, row); PG8_GAS bf16_t* rowp = Q + (size_t)row * 2048 + u.ocol + wc * 32 + 8 * fq + 4 * wr;
#pragma unroll
        for (int bj = 0; bj < 2; ++bj) { u32x2 w; w.x = cvt_pk_bf16(as[bj][0] * rs, as[bj][1] * rs); w.y = cvt_pk_bf16(as[bj][2] * rs, as[bj][3] * rs); *(PG8_GAS u32x2*)(rowp + bj * HALF) = w; }
    }
    __device__ __forceinline__ void operator()(const acc_t& acc, const GUnit& u, int wr, int wc, int fr, int fq) const {
        const int row0 = u.orow + wr * 64 + fr, col0 = u.ocol + wc * 32 + 8 * fq;
        const int rsrow0 = (u.kind == KIND_SLAB) ? mp + ((u.orow & 511) + wr * 64 + fr) : row0;
        float rsv[2][4]; rs8_of(RS, rsrow0, rsv);
        if (u.kind == KIND_SLAB) {
#pragma unroll
            for (int ai = 0; ai < 2; ++ai)
#pragma unroll
                for (int m = 0; m < 4; ++m) { PG8_GAS float* rowp = SL + (size_t)(row0 + ai * HALF + m * 16) * 2048 + col0; const float rs = rsv[ai][m];
#pragma unroll
                    for (int bj = 0; bj < 2; ++bj) { *(PG8_GAS f32x4*)(rowp + bj * HALF) = acc[ai][bj][m][0] * rs; *(PG8_GAS f32x4*)(rowp + bj * HALF + 4) = acc[ai][bj][m][1] * rs; } }
        } else {
#pragma unroll
            for (int ai = 0; ai < 2; ++ai)
#pragma unroll
                for (int m = 0; m < 4; ++m) { PG8_GAS bf16_t* rowp = Q + (size_t)(row0 + ai * HALF + m * 16) * 2048 + col0; const float rs = rsv[ai][m];
#pragma unroll
                    for (int bj = 0; bj < 2; ++bj) { const f32x4 v0 = acc[ai][bj][m][0] * rs, v1 = acc[ai][bj][m][1] * rs;
                        u32x4 w; w.x = cvt_pk_bf16(v0[0], v0[1]); w.y = cvt_pk_bf16(v0[2], v0[3]); w.z = cvt_pk_bf16(v1[0], v1[1]); w.w = cvt_pk_bf16(v1[2], v1[3]);
                        *(PG8_GAS u32x4*)(rowp + bj * HALF) = w; } }
        }
    }
};
struct EpiBf16 {
    static constexpr bool PERM = true, AFTER_DRAIN = false;
    PG8_GAS bf16_t* O; int ldo;
    __device__ __forceinline__ void operator()(const acc_t& acc, const GUnit& u, int wr, int wc, int fr, int fq) const {
        const int row0 = u.orow + wr * 64 + fr, col0 = u.ocol + wc * 32 + 8 * fq;
#pragma unroll
        for (int ai = 0; ai < 2; ++ai)
#pragma unroll
            for (int m = 0; m < 4; ++m) { PG8_GAS bf16_t* rowp = O + (size_t)(row0 + ai * HALF + m * 16) * ldo + col0;
#pragma unroll
                for (int bj = 0; bj < 2; ++bj) { const f32x4 v0 = acc[ai][bj][m][0], v1 = acc[ai][bj][m][1];
                    u32x4 w; w.x = cvt_pk_bf16(v0[0], v0[1]); w.y = cvt_pk_bf16(v0[2], v0[3]); w.z = cvt_pk_bf16(v1[0], v1[1]); w.w = cvt_pk_bf16(v1[2], v1[3]);
                    *(PG8_GAS u32x4*)(rowp + bj * HALF) = w; } }
    }
};
struct EpiSoftmax {
    static constexpr bool PERM = true, AFTER_DRAIN = true;
    PG8_GAS bf16_t* P; int ldp; float scale_log2e;
    __device__ __forceinline__ void fused(acc_t& acc, const GUnit& u, int wr, int wc, int fr, int fq, PG8_LAS unsigned char* lds, int wid, int lane) const {
        PG8_LAS float* RM = (PG8_LAS float*)lds;
        PG8_LAS float* RS = (PG8_LAS float*)(lds + 4096);
#pragma unroll
        for (int ai = 0; ai < 2; ++ai)
#pragma unroll
            for (int m = 0; m < 4; ++m) { float mx = -3.0e38f;
#pragma unroll
                for (int bj = 0; bj < 2; ++bj)
#pragma unroll
                    for (int n = 0; n < 2; ++n) { const f32x4 x = acc[ai][bj][m][n]; mx = fmaxf(mx, fmaxf(fmaxf(x[0], x[1]), fmaxf(x[2], x[3]))); }
                mx = fmaxf(mx, pg8::shx(mx, 16)); mx = fmaxf(mx, pg8::shx(mx, 32));
                if (fq == 0) RM[(ai * HALF + wr * 64 + m * 16 + fr) * 4 + wc] = mx; }
        asm volatile("s_waitcnt lgkmcnt(0)" ::: "memory"); __builtin_amdgcn_s_barrier(); asm volatile("" ::: "memory");
#pragma unroll
        for (int ai = 0; ai < 2; ++ai)
#pragma unroll
            for (int m = 0; m < 4; ++m) { const int r = ai * HALF + wr * 64 + m * 16 + fr; const f32x4 mm = *(const PG8_LAS f32x4*)(RM + r * 4);
                const float mx = fmaxf(fmaxf(mm[0], mm[1]), fmaxf(mm[2], mm[3])) * scale_log2e; float s = 0.f;
#pragma unroll
                for (int bj = 0; bj < 2; ++bj)
#pragma unroll
                    for (int n = 0; n < 2; ++n) { f32x4 x = acc[ai][bj][m][n];
#pragma unroll
                        for (int j = 0; j < 4; ++j) { x[j] = __builtin_amdgcn_exp2f(x[j] * scale_log2e - mx); s += x[j]; }
                        acc[ai][bj][m][n] = x; }
                s += pg8::shx(s, 16); s += pg8::shx(s, 32);
                if (fq == 0) RS[r * 4 + wc] = s; }
        asm volatile("s_waitcnt lgkmcnt(0)" ::: "memory"); __builtin_amdgcn_s_barrier(); asm volatile("" ::: "memory");
        const int row0 = u.orow + wr * 64 + fr, col0 = u.ocol + wc * 32 + 8 * fq;
#pragma unroll
        for (int ai = 0; ai < 2; ++ai)
#pragma unroll
            for (int m = 0; m < 4; ++m) { const int r = ai * HALF + wr * 64 + m * 16 + fr; const f32x4 ss = *(const PG8_LAS f32x4*)(RS + r * 4);
                const float inv = 1.0f / ((ss[0] + ss[1]) + (ss[2] + ss[3])); PG8_GAS bf16_t* rowp = P + (size_t)(row0 + ai * HALF + m * 16) * ldp + col0;
#pragma unroll
                for (int bj = 0; bj < 2; ++bj) { const f32x4 v0 = acc[ai][bj][m][0] * inv, v1 = acc[ai][bj][m][1] * inv;
                    u32x4 w; w.x = cvt_pk_bf16(v0[0], v0[1]); w.y = cvt_pk_bf16(v0[2], v0[3]); w.z = cvt_pk_bf16(v1[0], v1[1]); w.w = cvt_pk_bf16(v1[2], v1[3]);
                    *(PG8_GAS u32x4*)(rowp + bj * HALF) = w; } }
        asm volatile("s_waitcnt lgkmcnt(0)" ::: "memory"); __builtin_amdgcn_s_barrier(); asm volatile("" ::: "memory");
    }
};
struct EpiT {
    static constexpr bool PERM = true, AFTER_DRAIN = true;
    const PG8_GAS float* XF0; const PG8_GAS float* XF1;
    PG8_GAS bf16_t* XH; PG8_GAS float* OUT; const PG8_GAS float* G1; float c;
    PG8_GAS float* XB; PG8_GAS unsigned* CNT; PG8_GAS float* SSQ; int mode;
    __device__ __forceinline__ void fused(acc_t& acc, f32x4 (&as)[2], const GUnit& u, int wr, int wc, int fr, int fq, PG8_LAS unsigned char* lds, int wid, int lane) const {
        PG8_LAS float* PW = (PG8_LAS float*)(lds + STAGE_BYTES);
        PG8_LAS float* PS = (PG8_LAS float*)(lds + STAGE_BYTES + 4096);
        PG8_LAS float* SR = (PG8_LAS float*)(lds + STAGE_BYTES + 4608);
        const int pm = u.orow >> 8, pn = u.ocol >> 8, tid = wid * 64 + lane;
        unsigned ldsx_ = (unsigned)(size_t)(lds + wid * 1024); asm volatile("" : "+s"(ldsx_));
        PG8_LAS unsigned char* ldsx = (PG8_LAS unsigned char*)(size_t)ldsx_;
        if (mode != 1) {
#pragma unroll
            for (int ai = 0; ai < 2; ++ai)
#pragma unroll
                for (int m = 0; m < 4; ++m)
#pragma unroll
                    for (int bj = 0; bj < 2; ++bj)
                        __builtin_amdgcn_global_load_lds((const PG8_GAS unsigned*)(XH + (size_t)(u.orow + ai * HALF + wr * 64 + m * 16 + fr) * 2048 + u.ocol + bj * HALF + wc * 32 + 8 * fq),
                                                         (PG8_LAS unsigned*)(ldsx + ((ai * 4 + m) * 2 + bj) * 8192), 16, 0, 0);
        }
#pragma unroll
        for (int ai = 0; ai < 2; ++ai)
#pragma unroll
            for (int m = 0; m < 4; ++m) { float q = 0.f;
#pragma unroll
                for (int bj = 0; bj < 2; ++bj)
#pragma unroll
                    for (int n = 0; n < 2; ++n) { const f32x4 v = acc[ai][bj][m][n]; q += (v[0] * v[0] + v[1] * v[1]) + (v[2] * v[2] + v[3] * v[3]); }
                q += pg8::shx(q, 16); q += pg8::shx(q, 32);
                if (fq == 0) PW[(ai * HALF + wr * 64 + m * 16 + fr) * 4 + wc] = q; }
        { float q = 0.f;
#pragma unroll
            for (int bj = 0; bj < 2; ++bj) { const f32x4 v = as[bj]; q += (v[0] * v[0] + v[1] * v[1]) + (v[2] * v[2] + v[3] * v[3]); }
            q += pg8::shx(q, 16); q += pg8::shx(q, 32);
            if (fq == 0) PS[fr * 8 + wid] = q; }
        asm volatile("s_waitcnt lgkmcnt(0)" ::: "memory"); __builtin_amdgcn_s_barrier(); asm volatile("" ::: "memory");
        PG8_GAS float* xb = XB + ((size_t)pm * 272) * 8;
        if (tid < 272) { float p;
            if (tid < 256) { const f32x4 t = *(const PG8_LAS f32x4*)(PW + tid * 4); p = (t[0] + t[1]) + (t[2] + t[3]); }
            else { const f32x4 t0 = *(const PG8_LAS f32x4*)(PS + (tid - 256) * 8), t1 = *(const PG8_LAS f32x4*)(PS + (tid - 256) * 8 + 4); p = ((t0[0] + t0[1]) + (t0[2] + t0[3])) + ((t1[0] + t1[1]) + (t1[2] + t1[3])); }
            __hip_atomic_store((PG8_GAS unsigned*)(xb + (size_t)tid * 8 + pn), __float_as_uint(p), __ATOMIC_RELAXED, __HIP_MEMORY_SCOPE_AGENT); }
        asm volatile("s_waitcnt vmcnt(0)" ::: "memory"); __builtin_amdgcn_s_barrier(); asm volatile("" ::: "memory");
        if (tid == 0) (void)__hip_atomic_fetch_add(CNT + 16 * pm, 1u, __ATOMIC_RELAXED, __HIP_MEMORY_SCOPE_AGENT);
        if (wid == 0) { unsigned spins = 0;
            while ((unsigned)__builtin_amdgcn_readfirstlane((int)__hip_atomic_load(CNT + 16 * pm, __ATOMIC_RELAXED, __HIP_MEMORY_SCOPE_AGENT)) < 8u) { __builtin_amdgcn_s_sleep(1); if (++spins > (1u << 20)) break; }
            __builtin_amdgcn_fence(__ATOMIC_ACQUIRE, "agent"); asm volatile("s_waitcnt vmcnt(0)" ::: "memory"); }
        __builtin_amdgcn_s_barrier(); asm volatile("" ::: "memory");
        if (tid < 272) { float sum = 0.f;
#pragma unroll
            for (int k = 0; k < 8; ++k) sum += __uint_as_float(__hip_atomic_load((PG8_GAS unsigned*)(xb + (size_t)tid * 8 + k), __ATOMIC_RELAXED, __HIP_MEMORY_SCOPE_AGENT));
            SR[tid] = c * __builtin_amdgcn_rsqf(sum * (1.0f / 2048.0f) + 1e-6f); }
        asm volatile("s_waitcnt lgkmcnt(0)" ::: "memory"); __builtin_amdgcn_s_barrier(); asm volatile("" ::: "memory");
        asm volatile("s_waitcnt vmcnt(0)" ::: "memory");
#pragma unroll
        for (int ai = 0; ai < 2; ++ai)
#pragma unroll
            for (int m = 0; m < 4; ++m) { const int rl = ai * HALF + wr * 64 + m * 16 + fr, grow = u.orow + rl; const float sc = SR[rl]; float q = 0.f;
#pragma unroll
                for (int bj = 0; bj < 2; ++bj) { const int col = u.ocol + bj * HALF + wc * 32 + 8 * fq; const size_t o = (size_t)grow * 2048 + col;
                    f32x4 x0, x1;
                    if (mode == 1) { x0 = *(const PG8_GAS f32x4*)(XF0 + o); x1 = *(const PG8_GAS f32x4*)(XF0 + o + 4); }
                    else { const u32x4 w = *(const PG8_LAS u32x4*)(lds + ((ai * 4 + m) * 2 + bj) * 8192 + wid * 1024 + lane * 16);
                        x0 = (f32x4){__uint_as_float(w.x << 16), __uint_as_float(w.x & 0xffff0000u), __uint_as_float(w.y << 16), __uint_as_float(w.y & 0xffff0000u)};
                        x1 = (f32x4){__uint_as_float(w.z << 16), __uint_as_float(w.z & 0xffff0000u), __uint_as_float(w.w << 16), __uint_as_float(w.w & 0xffff0000u)}; }
                    const f32x4 g0 = *(const PG8_GAS f32x4*)(G1 + col), g1v = *(const PG8_GAS f32x4*)(G1 + col + 4);
                    x0 = x0 + acc[ai][bj][m][0] * sc * g0; x1 = x1 + acc[ai][bj][m][1] * sc * g1v;
                    if (mode == 2) { *(PG8_GAS f32x4*)(OUT + o) = x0; *(PG8_GAS f32x4*)(OUT + o + 4) = x1; }
                    else { u32x4 w; w.x = cvt_pk_bf16(x0[0], x0[1]); w.y = cvt_pk_bf16(x0[2], x0[3]); w.z = cvt_pk_bf16(x1[0], x1[1]); w.w = cvt_pk_bf16(x1[2], x1[3]); *(PG8_GAS u32x4*)(XH + o) = w;
                        q += ((x0[0] * x0[0] + x0[1] * x0[1]) + (x0[2] * x0[2] + x0[3] * x0[3])) + ((x1[0] * x1[0] + x1[1] * x1[1]) + (x1[2] * x1[2] + x1[3] * x1[3])); } }
                q += pg8::shx(q, 16); q += pg8::shx(q, 32);
                if (fq == 0) PW[rl * 4 + wc] = q; }
        { const int grow = u.srow + fr; const float sc = SR[256 + fr]; float q = 0.f;
#pragma unroll
            for (int bj = 0; bj < 2; ++bj) { const int col = u.ocol + bj * HALF + wc * 32 + 8 * fq + 4 * wr; const size_t o = (size_t)grow * 2048 + col;
                f32x4 x0;
                if (mode == 1) x0 = *(const PG8_GAS f32x4*)(XF1 + (size_t)(grow - 8192) * 2048 + col);
                else { const u32x2 w = *(const PG8_GAS u32x2*)(XH + o); x0 = (f32x4){__uint_as_float(w.x << 16), __uint_as_float(w.x & 0xffff0000u), __uint_as_float(w.y << 16), __uint_as_float(w.y & 0xffff0000u)}; }
                const f32x4 g0 = *(const PG8_GAS f32x4*)(G1 + col);
                x0 = x0 + as[bj] * sc * g0;
                if (mode == 2) *(PG8_GAS f32x4*)(OUT + o) = x0;
                else { u32x2 w; w.x = cvt_pk_bf16(x0[0], x0[1]); w.y = cvt_pk_bf16(x0[2], x0[3]); *(PG8_GAS u32x2*)(XH + o) = w; q += (x0[0] * x0[0] + x0[1] * x0[1]) + (x0[2] * x0[2] + x0[3] * x0[3]); } }
            q += pg8::shx(q, 16); q += pg8::shx(q, 32);
            if (fq == 0) PS[fr * 8 + wid] = q; }
        asm volatile("s_waitcnt lgkmcnt(0)" ::: "memory"); __builtin_amdgcn_s_barrier(); asm volatile("" ::: "memory");
        if (mode != 2 && tid < 272) { float p; int grow;
            if (tid < 256) { const f32x4 t = *(const PG8_LAS f32x4*)(PW + tid * 4); p = (t[0] + t[1]) + (t[2] + t[3]); grow = u.orow + tid; }
            else { const f32x4 t0 = *(const PG8_LAS f32x4*)(PS + (tid - 256) * 8), t1 = *(const PG8_LAS f32x4*)(PS + (tid - 256) * 8 + 4); p = ((t0[0] + t0[1]) + (t0[2] + t0[3])) + ((t1[0] + t1[1]) + (t1[2] + t1[3])); grow = u.srow + (tid - 256); }
            SSQ[(size_t)grow * 8 + pn] = p; }
        asm volatile("s_waitcnt lgkmcnt(0)" ::: "memory"); __builtin_amdgcn_s_barrier(); asm volatile("" ::: "memory");
    }
};
}

constexpr int NWAVES = 8;
constexpr int DM = 2048, NB = 4, SEQ = 2048, DEPTH = 2, DECB = 128, DECS = 4;
constexpr int DLRU = 1024, DSGU = 1024, CHUNK = 128, MEML = 256, XAH = 4, XAD = 512, DFF = 5504;
constexpr int MP = NB * SEQ;
constexpr int MS = DECB * DECS;
constexpr int MT = MP + MS;
constexpr int MMEM = NB * MEML;
constexpr float EPS = 1e-6f;

constexpr size_t al256(size_t x) { return (x + 255) & ~(size_t)255; }
constexpr size_t WS_CTL = 0, CTL_ZERO_BYTES = 1u << 20;
constexpr size_t WL_FIN1 = 0;
constexpr size_t WL_FDN1 = WL_FIN1 + (size_t)2 * DFF * DM * 2;
constexpr size_t WL_WIN  = WL_FDN1 + (size_t)DM * DFF * 2;
constexpr size_t WL_WOUT = WL_WIN + (size_t)4096 * DM * 2;
constexpr size_t WL_WQ   = WL_WOUT + (size_t)DM * DM * 2;
constexpr size_t WL_WKV  = WL_WQ + (size_t)DM * DM * 2;
constexpr size_t WL_WO   = WL_WKV + (size_t)4096 * DM * 2;
constexpr size_t WL_FIN2 = WL_WO + (size_t)DM * DM * 2;
constexpr size_t WL_FDN2 = WL_FIN2 + (size_t)2 * DFF * DM * 2;
constexpr size_t WL_LRA  = WL_FDN2 + (size_t)DM * DFF * 2;
constexpr size_t WL_LRI  = WL_LRA + (size_t)8 * 128 * 128 * 2;
constexpr size_t WL_SGW  = WL_LRI + (size_t)8 * 128 * 128 * 2;
constexpr size_t WL_SIZE = al256(WL_SGW + (size_t)8 * 128 * 128 * 2);
constexpr size_t WS_W = CTL_ZERO_BYTES;
constexpr size_t WS_XB   = WS_W + DEPTH * WL_SIZE;
constexpr size_t WS_HB   = WS_XB + (size_t)MT * DM * 4;
constexpr size_t WS_ACT  = WS_HB + (size_t)MT * DM * 2;
constexpr size_t WS_DB   = WS_ACT + (size_t)MT * DFF * 2;
constexpr size_t WS_XL   = WS_DB + (size_t)MT * DM * 4;
constexpr size_t WS_GL   = WS_XL + (size_t)MT * 1024 * 4;
constexpr size_t WS_UG   = WS_GL + (size_t)MT * 1024 * 2;
constexpr size_t WS_VG   = WS_UG + (size_t)MT * 1024 * 2;
constexpr size_t WS_VST  = WS_VG + (size_t)MT * 1024 * 4;
constexpr size_t WS_HLOC = WS_VST + (size_t)MT * 32 * 4;
constexpr size_t WS_PC   = WS_HLOC + (size_t)MP * 1024 * 4;
constexpr size_t WS_CSUM = WS_PC + (size_t)MP * 1024 * 4;
constexpr size_t WS_YMIX = WS_CSUM + (size_t)4 * 16 * 1024 * 2 * 4;
constexpr size_t WS_QB   = WS_YMIX + (size_t)MT * DM * 2;
constexpr size_t WS_PB   = WS_QB + (size_t)MT * DM * 2;
constexpr size_t WS_OB   = WS_PB + (size_t)MP * 1024 * 2;
constexpr size_t WS_MEMN = WS_OB + (size_t)MT * DM * 2;
constexpr size_t WS_KB   = WS_MEMN + (size_t)DEPTH * MMEM * DM * 2;
constexpr size_t WS_VT   = WS_KB + (size_t)MMEM * DM * 2;
constexpr size_t WS_SLAB = WS_VT + (size_t)DM * MMEM * 2;
constexpr int NSPLIT = 8;
constexpr size_t WS_RS   = WS_SLAB + (size_t)NSPLIT * MS * 4096 * 4;
constexpr size_t WS_TXB  = al256(WS_RS + (size_t)MT * 8 * 4);
constexpr size_t WS_CS   = al256(WS_TXB + (size_t)8 * 32 * 272 * 8 * 4);
constexpr size_t WS_END  = WS_CS + (size_t)DEPTH * 512 * 128 * 8;

constexpr size_t OUT_YP = 0, OUT_YS = OUT_YP + (size_t)MP * DM, OUT_MK = OUT_YS + (size_t)MS * DM, OUT_MV = OUT_MK + (size_t)DEPTH * MMEM * DM,
                 OUT_CVP = OUT_MV + (size_t)DEPTH * MMEM * DM, OUT_HP = OUT_CVP + (size_t)DEPTH * NB * 3 * DLRU, OUT_CVS = OUT_HP + (size_t)DEPTH * NB * DLRU,
                 OUT_HS = OUT_CVS + (size_t)DEPTH * DECB * 3 * DLRU, OUT_VS = OUT_HS + (size_t)DEPTH * DECB * DLRU, OUT_END = OUT_VS + (size_t)DEPTH * DECB * DECS * DSGU;

constexpr int CW_BAR = 4096;
constexpr int CW_LRUF = 16384;
constexpr int CW_TC = 49152;
constexpr int CW_XF = 57344;
constexpr int CW_QC = 40960;

constexpr int RING_BYTES = 131072;
constexpr int LDS_BYTES = 155648;
constexpr int MISC_OFF = LDS_BYTES - 256;
constexpr int TAB_OFF = LDS_BYTES - 768;

#define GAS __attribute__((address_space(1)))
#define LAS __attribute__((address_space(3)))
typedef unsigned short bf16;
typedef unsigned v4u __attribute__((ext_vector_type(4)));
typedef unsigned v2u __attribute__((ext_vector_type(2)));
typedef float f32x4 __attribute__((ext_vector_type(4)));
typedef float f32x2 __attribute__((ext_vector_type(2)));
typedef short bf16x8 __attribute__((ext_vector_type(8)));
typedef GAS unsigned gu32;
#define RLX_AGENT __ATOMIC_RELAXED, __HIP_MEMORY_SCOPE_AGENT
#define LDS_WAIT() asm volatile("s_waitcnt lgkmcnt(0)" ::: "memory")
#define VM_WAIT() asm volatile("s_waitcnt vmcnt(0)" ::: "memory")
__device__ __forceinline__ unsigned f2bf(float f) { unsigned u = __builtin_bit_cast(unsigned, f); return (u + 0x7fffu + ((u >> 16) & 1u)) >> 16; }
__device__ __forceinline__ unsigned pk2(float lo, float hi) { return f2bf(lo) | (f2bf(hi) << 16); }
__device__ __forceinline__ float bf2f(unsigned short b) { return __builtin_bit_cast(float, (unsigned)b << 16); }
__device__ __forceinline__ float bflo(unsigned w) { return __builtin_bit_cast(float, w << 16); }
__device__ __forceinline__ float bfhi(unsigned w) { return __builtin_bit_cast(float, w & 0xffff0000u); }

#define XB_TMO      128
#define XB_XCNT(j)  (256  + 64 * (j))
#define XB_XSUB(j)  (1280 + 64 * (j))
#define XB_XGEN(j)  (2304 + 64 * (j))
#define XB_TOP      3328
#define XB_TOPGEN   3392
#define XCD_BAR_WORDS 3456
#define XB_SPIN_CAP (1u << 18)

__device__ __forceinline__ unsigned xb_ld(GAS unsigned* p)              { return __hip_atomic_load(p, __ATOMIC_RELAXED, __HIP_MEMORY_SCOPE_AGENT); }
__device__ __forceinline__ unsigned xb_add(GAS unsigned* p, unsigned v) { return __hip_atomic_fetch_add(p, v, __ATOMIC_RELAXED, __HIP_MEMORY_SCOPE_AGENT); }
__device__ __forceinline__ unsigned xb_xcc_id() { return (unsigned)__builtin_amdgcn_s_getreg((3 << 11) | 20) & 0xFu; }
#define XB_SPIN(cond, bar) do { unsigned _sp = 0; while (cond) { __builtin_amdgcn_s_sleep(1); \
    if ((++_sp & 255u) == 0u) { if (xb_ld(&(bar)[XB_TMO])) break; if (_sp > XB_SPIN_CAP) { xb_add(&(bar)[XB_TMO], 1u); break; } } } } while (0)

struct XcdBarrier {
    GAS unsigned* bar; unsigned x;
    volatile LAS unsigned* st;
};
__device__ __forceinline__ XcdBarrier xcd_barrier_post(GAS unsigned* bar, volatile LAS unsigned* st, bool t0) {
    XcdBarrier b; b.bar = bar; b.x = xb_xcc_id(); b.st = st;
    if (t0) (void)xb_add(&bar[XB_XCNT(b.x)], 1u);
    return b;
}
__device__ __forceinline__ void xcd_barrier_complete(GAS unsigned* bar, unsigned x, unsigned& nloc, unsigned& nx) {
    const unsigned G = gridDim.x * gridDim.y * gridDim.z;
    unsigned sum, cnt, mine, sp = 0u;
    for (;;) {
        sum = 0u; cnt = 0u; mine = 0u;
#pragma unroll
        for (unsigned j = 0; j < 16; ++j) { const unsigned c = xb_ld(&bar[XB_XCNT(j)]); sum += c; cnt += (c > 0u) ? 1u : 0u; mine = (j == x) ? c : mine; }
        if (sum == G) break;
        __builtin_amdgcn_s_sleep(1);
        if ((++sp & 255u) == 0u) { if (xb_ld(&bar[XB_TMO])) break; if (sp > XB_SPIN_CAP) { xb_add(&bar[XB_TMO], 1u); break; } }
    }
    nloc = mine > 0u ? mine : 1u; nx = cnt > 0u ? cnt : 1u;
}
__device__ __forceinline__ void xcd_barrier(const XcdBarrier& b, bool t0) {
    asm volatile("s_waitcnt vmcnt(0)" ::: "memory");
    __syncthreads();
    if (t0) {
        GAS unsigned* bar = b.bar;
        __builtin_amdgcn_s_waitcnt(0);
        unsigned nloc = b.st[0], nx = b.st[1];
        if (nloc == 0u) { xcd_barrier_complete(bar, b.x, nloc, nx); b.st[0] = nloc; b.st[1] = nx; }
        const unsigned old = xb_add(&bar[XB_XSUB(b.x)], 1u);
        const unsigned gen = old / nloc;
        if (old + 1u == (gen + 1u) * nloc) {
            __builtin_amdgcn_fence(__ATOMIC_RELEASE, "agent");
            asm volatile("s_waitcnt vmcnt(0)" ::: "memory");
            const unsigned og = xb_add(&bar[XB_TOP], 1u);
            const unsigned tg = og / nx;
            if (og + 1u == (tg + 1u) * nx) xb_add(&bar[XB_TOPGEN], 1u);
            else XB_SPIN(xb_ld(&bar[XB_TOPGEN]) == tg, bar);
            __builtin_amdgcn_fence(__ATOMIC_ACQUIRE, "agent");
            xb_add(&bar[XB_XGEN(b.x)], 1u);
            asm volatile("s_waitcnt vmcnt(0)" ::: "memory");
        } else {
            XB_SPIN(xb_ld(&bar[XB_XGEN(b.x)]) == gen, bar);
            __builtin_amdgcn_fence(__ATOMIC_ACQUIRE, "agent");
            asm volatile("s_waitcnt vmcnt(0)" ::: "memory");
        }
    }
    __syncthreads();
}

struct Args { const float* in[30]; float* out; unsigned char* ws; int ph_lo, ph_hi; };
typedef const GAS float* cgf; typedef GAS float* gf; typedef const GAS bf16* cgb; typedef GAS bf16* gb; typedef GAS unsigned char* gu8; typedef const GAS char* cgc;

__device__ __forceinline__ unsigned long long tab_ld(LAS unsigned char* lds, int i) {
    const unsigned long long v = *(const LAS unsigned long long*)(lds + TAB_OFF + 8 * i);
    return ((unsigned long long)(unsigned)__builtin_amdgcn_readfirstlane((int)(unsigned)(v >> 32)) << 32) | (unsigned long long)(unsigned)__builtin_amdgcn_readfirstlane((int)(unsigned)v);
}
#define TIN(i) ((cgf)tab_ld(lds, (i)))
#define TOUT() ((gf)tab_ld(lds, 30))
#define TWS() ((gu8)tab_ld(lds, 31))

__device__ __forceinline__ float wave_sum(float v) {
#pragma unroll
    for (int o = 1; o < 64; o <<= 1) v += pg8::shx(v, o);
    return v;
}
__device__ __forceinline__ float wave_max(float v) {
#pragma unroll
    for (int o = 1; o < 64; o <<= 1) v = fmaxf(v, pg8::shx(v, o));
    return v;
}

__device__ __forceinline__ void p0_transpose_item(cgf W, int K, int N, gb WT, int k0, int n0, int orow0, LAS float* scr, int lane, cgf gain = nullptr) {
    if (gain) {
#pragma unroll 8
        for (int i = 0; i < 32; ++i) { const int kk = 2 * i + (lane >> 5); scr[kk * 33 + (lane & 31)] = W[(size_t)(k0 + kk) * N + n0 + (lane & 31)] * gain[k0 + kk]; }
    } else {
#pragma unroll 8
    for (int i = 0; i < 32; ++i) { const int kk = 2 * i + (lane >> 5); scr[kk * 33 + (lane & 31)] = W[(size_t)(k0 + kk) * N + n0 + (lane & 31)]; }
    }
    LDS_WAIT(); asm volatile("" ::: "memory");
    const int c = lane & 7;
#pragma unroll
    for (int j = 0; j < 4; ++j) { const int n = (lane >> 3) + 8 * j; const LAS float* s = scr + (8 * c) * 33 + n;
        v4u o; o.x = pk2(s[0 * 33], s[1 * 33]); o.y = pk2(s[2 * 33], s[3 * 33]); o.z = pk2(s[4 * 33], s[5 * 33]); o.w = pk2(s[6 * 33], s[7 * 33]);
        *(GAS v4u*)(WT + (size_t)(orow0 + n) * K + k0 + 8 * c) = o; }
    LDS_WAIT(); asm volatile("" ::: "memory");
}
__device__ __forceinline__ void p0_mat(cgf W, int K, int N, gb WT, int item, LAS float* scr, int lane, cgf gain = nullptr) {
    const int nblk = N / 32, kb = item / nblk, nb = item % nblk;
    p0_transpose_item(W, K, N, WT, 64 * kb, 32 * nb, 32 * nb, scr, lane, gain);
}
__device__ __forceinline__ void p0_mat_ffn_in(cgf W, gb WT, int item, LAS float* scr, int lane, cgf gain) {
    constexpr int N = 2 * DFF, nblk = N / 32; const int kb = item / nblk, nb = item % nblk; const int n0 = 32 * nb;
    const int j0 = (n0 < DFF) ? n0 : n0 - DFF; const int orow0 = (j0 >> 7) * 256 + (j0 & 127) + ((n0 < DFF) ? 0 : 128);
    p0_transpose_item(W, DM, N, WT, 64 * kb, n0, orow0, scr, lane, gain);
}
__device__ __forceinline__ void rms_row_to_bf16(cgf xrow, cgf g, gb orow, int lane) {
    const GAS f32x4* xr = (const GAS f32x4*)xrow + lane; const GAS f32x4* gr = (const GAS f32x4*)g + lane;
    f32x4 v[8]; float s = 0.f;
#pragma unroll
    for (int j = 0; j < 8; ++j) { v[j] = xr[64 * j]; s += (v[j].x * v[j].x + v[j].y * v[j].y) + (v[j].z * v[j].z + v[j].w * v[j].w); }
    const float rstd = 1.0f / sqrtf(wave_sum(s) * (1.f / DM) + EPS);
    GAS v2u* o8 = (GAS v2u*)orow + lane;
#pragma unroll
    for (int j = 0; j < 8; ++j) { const f32x4 gg = gr[64 * j]; v2u o; o.x = pk2(v[j].x * rstd * gg.x, v[j].y * rstd * gg.y); o.y = pk2(v[j].z * rstd * gg.z, v[j].w * rstd * gg.w); o8[64 * j] = o; }
}
__device__ __forceinline__ void x_row_init(cgf xrow, gb orow, gf rs, int lane) {
    float s = 0.f;
#pragma unroll
    for (int j = 0; j < 4; ++j) { const int col = j * 512 + lane * 8; const f32x4 a = *(const GAS f32x4*)(xrow + col), b = *(const GAS f32x4*)(xrow + col + 4);
        s += (a.x * a.x + a.y * a.y) + (a.z * a.z + a.w * a.w) + (b.x * b.x + b.y * b.y) + (b.z * b.z + b.w * b.w);
        v4u o; o.x = pk2(a.x, a.y); o.y = pk2(a.z, a.w); o.z = pk2(b.x, b.y); o.w = pk2(b.z, b.w); *(GAS v4u*)(orow + col) = o; }
    s = wave_sum(s);
    if (lane == 0) { *(GAS f32x4*)rs = (f32x4){s, 0.f, 0.f, 0.f}; *(GAS f32x4*)(rs + 4) = (f32x4){0.f, 0.f, 0.f, 0.f}; }
}
template <bool FIRST, bool LAST, bool SLABS>
__device__ __forceinline__ void t_row(cgf xf, cgb xh, cgb dh, cgf dsl, cgf g1, float c, gb xo, gf of, gf rs, int lane) {
    float x[32], d[32]; float s = 0.f;
#pragma unroll
    for (int j = 0; j < 4; ++j) { const int col = j * 512 + lane * 8;
        if constexpr (SLABS) { f32x4 a = *(const GAS f32x4*)(dsl + col), b = *(const GAS f32x4*)(dsl + col + 4);
#pragma unroll
            for (int sp = 1; sp < NSPLIT; ++sp) { a = a + *(const GAS f32x4*)(dsl + (size_t)sp * MS * DM + col); b = b + *(const GAS f32x4*)(dsl + (size_t)sp * MS * DM + col + 4); }
            d[8 * j + 0] = a.x; d[8 * j + 1] = a.y; d[8 * j + 2] = a.z; d[8 * j + 3] = a.w; d[8 * j + 4] = b.x; d[8 * j + 5] = b.y; d[8 * j + 6] = b.z; d[8 * j + 7] = b.w;
        } else { const v4u w = *(const GAS v4u*)(dh + col);
            d[8 * j + 0] = bflo(w.x); d[8 * j + 1] = bfhi(w.x); d[8 * j + 2] = bflo(w.y); d[8 * j + 3] = bfhi(w.y); d[8 * j + 4] = bflo(w.z); d[8 * j + 5] = bfhi(w.z); d[8 * j + 6] = bflo(w.w); d[8 * j + 7] = bfhi(w.w); }
        if constexpr (FIRST) { const f32x4 a = *(const GAS f32x4*)(xf + col), b = *(const GAS f32x4*)(xf + col + 4);
            x[8 * j + 0] = a.x; x[8 * j + 1] = a.y; x[8 * j + 2] = a.z; x[8 * j + 3] = a.w; x[8 * j + 4] = b.x; x[8 * j + 5] = b.y; x[8 * j + 6] = b.z; x[8 * j + 7] = b.w;
        } else { const v4u w = *(const GAS v4u*)(xh + col);
            x[8 * j + 0] = bflo(w.x); x[8 * j + 1] = bfhi(w.x); x[8 * j + 2] = bflo(w.y); x[8 * j + 3] = bfhi(w.y); x[8 * j + 4] = bflo(w.z); x[8 * j + 5] = bfhi(w.z); x[8 * j + 6] = bflo(w.w); x[8 * j + 7] = bfhi(w.w); } }
#pragma unroll
    for (int e = 0; e < 32; ++e) s += d[e] * d[e];
    const float rd = c / sqrtf(wave_sum(s) * (1.f / DM) + EPS);
    float s2 = 0.f;
#pragma unroll
    for (int j = 0; j < 4; ++j) { const int col = j * 512 + lane * 8; const f32x4 ga = *(const GAS f32x4*)(g1 + col), gb_ = *(const GAS f32x4*)(g1 + col + 4);
        x[8 * j + 0] += d[8 * j + 0] * rd * ga.x; x[8 * j + 1] += d[8 * j + 1] * rd * ga.y; x[8 * j + 2] += d[8 * j + 2] * rd * ga.z; x[8 * j + 3] += d[8 * j + 3] * rd * ga.w;
        x[8 * j + 4] += d[8 * j + 4] * rd * gb_.x; x[8 * j + 5] += d[8 * j + 5] * rd * gb_.y; x[8 * j + 6] += d[8 * j + 6] * rd * gb_.z; x[8 * j + 7] += d[8 * j + 7] * rd * gb_.w;
        if constexpr (LAST) { *(GAS f32x4*)(of + col) = (f32x4){x[8 * j + 0], x[8 * j + 1], x[8 * j + 2], x[8 * j + 3]}; *(GAS f32x4*)(of + col + 4) = (f32x4){x[8 * j + 4], x[8 * j + 5], x[8 * j + 6], x[8 * j + 7]}; }
        else { v4u o; o.x = pk2(x[8 * j + 0], x[8 * j + 1]); o.y = pk2(x[8 * j + 2], x[8 * j + 3]); o.z = pk2(x[8 * j + 4], x[8 * j + 5]); o.w = pk2(x[8 * j + 6], x[8 * j + 7]); *(GAS v4u*)(xo + col) = o;
#pragma unroll
            for (int e = 0; e < 8; ++e) s2 += x[8 * j + e] * x[8 * j + e]; } }
    if constexpr (!LAST) { s2 = wave_sum(s2); if (lane == 0) *rs = 1.0f / sqrtf(s2 * (1.f / DM) + EPS); }
}

__device__ __forceinline__ void ksplit(int K, int s, int& koff, int& kt) {
    if (K == 2048) { koff = s * 256; kt = 4; }
    else { if (s < 3) { koff = s * 768; kt = 12; } else { koff = 2304 + (s - 3) * 640; kt = 10; } }
}
template <bool MIX>
struct SchedSplit {
    cgc A; cgc B; int lda, ldb, nN, K, G, c;
    __device__ __forceinline__ bool next(int i, pg8::GUnit& u) const {
        int L = i * G + c; const int NP = 32 * nN; int pm, pn;
        if (L < NP) { pg8::tile_of(L, 32, nN, pm, pn);
            u.a = A + (size_t)pm * 256 * lda * 2; u.b = B + (size_t)pn * 256 * ldb * 2; u.orow = pm * 256; u.nt = K / 64;
            if (MIX) { u.ocol = (pn & 3) * 256; u.kind = pn >> 2; } else { u.ocol = pn * 256; u.kind = 0; }
            return true; }
        L -= NP; if (L >= 2 * nN * NSPLIT) return false;
        const int sp = L & (NSPLIT - 1), tile = L >> 3; pm = tile & 1; pn = tile >> 1;
        int koff, kt; ksplit(K, sp, koff, kt);
        u.a = A + ((size_t)(MP + pm * 256) * lda + koff) * 2; u.b = B + ((size_t)pn * 256 * ldb + koff) * 2;
        u.orow = sp * MS + pm * 256; u.ocol = pn * 256; u.kind = pg8::KIND_SLAB; u.nt = kt; return true;
    }
};
struct SchedMixIn {
    cgc A; cgc B; int G, c;
    __device__ __forceinline__ bool next(int i, pg8::GUnit& u) const {
        const int L = i * G + c; if (L >= (MT / 256) * 16) return false;
        int pm, pn; pg8::tile_of(L, MT / 256, 16, pm, pn);
        u.a = A + (size_t)pm * 256 * DM * 2; u.b = B + (size_t)pn * 256 * DM * 2; u.orow = pm * 256; u.ocol = (pn & 3) * 256; u.kind = pn >> 2; u.nt = DM / 64; return true;
    }
};
template <bool MIX>
struct SchedStrip {
    cgc A; cgc B; int lda, ldb, nN, K, G, c;
    __device__ __forceinline__ bool next(int i, pg8::GUnit& u) const {
        const int L = i * G + c; if (L >= 32 * nN) return false;
        int pm, pn; pg8::tile_of(L, 32, nN, pm, pn);
        u.a = A + (size_t)pm * 256 * lda * 2; u.sd = (MP + 16 * pm - 256 * pm) * lda * 2; u.srow = MP + 16 * pm; u.b = B + (size_t)pn * 256 * ldb * 2; u.orow = pm * 256; u.nt = K / 64;
        if (MIX) { u.ocol = (pn & 3) * 256; u.kind = pn >> 2; } else { u.ocol = pn * 256; u.kind = 0; }
        return true;
    }
};
struct SchedFfnIn {
    cgc H; cgc W; cgc MEMN; cgc WKV; int G, c, with_kv;
    static constexpr size_t TS = (size_t)256 * DM * 2;
    __device__ __forceinline__ bool next(int i, pg8::GUnit& u) const {
        int L = i * G + c; int pm, pn; u.nt = DM / 64; u.sd = 0; u.srow = 0;
        constexpr int N0 = (MT / 256) * (2 * DFF / 256), N1 = 32;
        if (L < N0) { pg8::tile_of(L, MT / 256, 2 * DFF / 256, pm, pn); u.a = H + pm * TS; u.b = W + pn * TS; u.orow = pm * 256; u.ocol = pn * 128; u.kind = 0; return true; }
        if (!with_kv) return false;
        L -= N0;
        if (L < N1) { pm = L & 3; pn = L >> 2; u.a = MEMN + pm * TS; u.b = WKV + pn * TS; u.orow = pm * 256; u.ocol = pn * 256; u.kind = 1; return true; }
        L -= N1;
        if (L < N1) { pm = L >> 2; pn = L & 3; u.a = WKV + (8 + pm) * TS; u.b = MEMN + pn * TS; u.orow = pm * 256; u.ocol = pn * 256; u.kind = 2; return true; }
        return false;
    }
};
struct SchedX1 {
    cgc Q; cgc KB; int G, c;
    __device__ __forceinline__ bool next(int i, pg8::GUnit& u) const {
        const int L = i * G + c; if (L >= NB * XAH * 8) return false;
        const int qb = L & 7, h = (L >> 3) & 3, n = L >> 5;
        u.a = Q + ((size_t)(n * SEQ + qb * 256) * DM + h * XAD) * 2; u.b = KB + ((size_t)(n * MEML) * DM + h * XAD) * 2;
        u.orow = n * SEQ + qb * 256; u.ocol = h * 256; u.kind = 0; u.nt = XAD / 64; u.sd = 0; u.srow = 0; return true;
    }
};
struct SchedX2 {
    cgc P; cgc VT; int G, c;
    __device__ __forceinline__ bool next(int i, pg8::GUnit& u) const {
        const int L = i * G + c; if (L >= NB * XAH * 8 * 2) return false;
        const int pn = L & 1, qb = (L >> 1) & 7, h = (L >> 4) & 3, n = L >> 6;
        u.a = P + ((size_t)(n * SEQ + qb * 256) * 1024 + h * 256) * 2; u.b = VT + ((size_t)(h * XAD + pn * 256) * 1024 + n * MEML) * 2;
        u.orow = n * SEQ + qb * 256; u.ocol = h * XAD + pn * 256; u.kind = 0; u.nt = MEML / 64; u.sd = 0; u.srow = 0; return true;
    }
};
struct SchedX2pair {
    cgc P; cgc VT; int cc;
    __device__ __forceinline__ bool next(int i, pg8::GUnit& u) const {
        if (cc < 0 || i >= 2) return false;
        const int pn = i, qb = cc & 7, h = (cc >> 3) & 3, n = cc >> 5;
        u.a = P + ((size_t)(n * SEQ + qb * 256) * 1024 + h * 256) * 2; u.b = VT + ((size_t)(h * XAD + pn * 256) * 1024 + n * MEML) * 2;
        u.orow = n * SEQ + qb * 256; u.ocol = h * XAD + pn * 256; u.kind = 0; u.nt = MEML / 64; u.sd = 0; u.srow = 0; return true;
    }
};

constexpr int LR_XC = 0;
constexpr int LR_A = 67584;
constexpr int LR_W = LR_A + 34816;
constexpr int LR_AA = LR_A;
constexpr int LR_SEG = LR_W + 34816;
constexpr int LR_PAR = LR_SEG + 4096;
static_assert(LR_AA + 67584 <= LR_SEG && LR_PAR + 1536 <= TAB_OFF, "LRU LDS map");

template <bool SAMPLE>
__device__ __forceinline__ void lru_unit(LAS unsigned char* lds, int l, int ui, int tid, int wave, int lane) {
    const int h = ui & 7, ch0 = h * 128;
    const int cidx = SAMPLE ? 0 : ((ui >> 3) & 15), n = SAMPLE ? 0 : (ui >> 7), blk = SAMPLE ? (ui >> 3) : 0;
    const int row0 = SAMPLE ? (MP + blk * 128) : (n * SEQ + cidx * 128);
    LAS float* XC = (LAS float*)(lds + LR_XC); LAS bf16* At = (LAS bf16*)(lds + LR_A); LAS bf16* Wt = (LAS bf16*)(lds + LR_W);
    LAS float* AA = (LAS float*)(lds + LR_AA); LAS float* SEG = (LAS float*)(lds + LR_SEG); LAS float* PAR = (LAS float*)(lds + LR_PAR);
    const int ch = tid & 127, rg = tid >> 7;
    const gu8 ws = TWS(); const gf out = TOUT();
    v4u wa_r[4], wi_r[4];
    { const GAS v4u* sa = (const GAS v4u*)(ws + WS_W + (size_t)l * WL_SIZE + WL_LRA + (size_t)h * 32768); const GAS v4u* si = (const GAS v4u*)(ws + WS_W + (size_t)l * WL_SIZE + WL_LRI + (size_t)h * 32768);
#pragma unroll
      for (int j = 0; j < 4; ++j) { wa_r[j] = sa[tid + 512 * j]; wi_r[j] = si[tid + 512 * j]; } }
    if (tid < 128) { PAR[tid] = TIN(15)[(size_t)l * DLRU + ch0 + tid]; PAR[128 + tid] = TIN(17)[(size_t)l * DLRU + ch0 + tid]; const float lm = TIN(18)[(size_t)l * DLRU + ch0 + tid]; PAR[256 + tid] = -8.0f * log1pf(expf(-lm)); }
    {
        const cgf cw = TIN(12) + (size_t)l * 4 * DLRU + ch0 + ch;
        const float w0 = cw[0], w1 = cw[DLRU], w2 = cw[2 * DLRU], w3 = cw[3 * DLRU], cbv = TIN(13)[(size_t)l * DLRU + ch0 + ch];
        const cgf xp = (cgf)(ws + WS_XL) + (size_t)(row0 + rg * 32) * DLRU + ch0 + ch;
        if constexpr (!SAMPLE) {
            float xm3 = 0.f, xm2 = 0.f, xm1 = 0.f;
            if (cidx > 0 || rg > 0) { xm3 = xp[-3 * DLRU]; xm2 = xp[-2 * DLRU]; xm1 = xp[-1 * DLRU]; }
            float xv[32];
#pragma unroll
            for (int r = 0; r < 32; ++r) xv[r] = xp[(size_t)r * DLRU];
#pragma unroll
            for (int r = 0; r < 32; ++r) { const float x0 = xv[r]; const float xc = cbv + w3 * x0 + w2 * xm1 + w1 * xm2 + w0 * xm3;
                XC[(rg * 32 + r) * 132 + ch] = xc; At[(rg * 32 + r) * 136 + ch] = (bf16)f2bf(xc); xm3 = xm2; xm2 = xm1; xm1 = x0; }
            if (cidx == 15 && rg == 3) { const gf o = out + OUT_CVP + ((size_t)l * NB + n) * 3 * DLRU + ch0 + ch; o[0] = xm3; o[DLRU] = xm2; o[2 * DLRU] = xm1; }
        } else {
#pragma unroll 2
            for (int e = 0; e < 8; ++e) { const int nb = blk * 32 + rg * 8 + e; const cgf sc = TIN(5) + ((size_t)l * DECB + nb) * 3 * DLRU + ch0 + ch;
                float xm3 = sc[0], xm2 = sc[DLRU], xm1 = sc[2 * DLRU];
#pragma unroll
                for (int t = 0; t < 4; ++t) { const int r = e * 4 + t; const float x0 = xp[(size_t)r * DLRU]; const float xc = cbv + w3 * x0 + w2 * xm1 + w1 * xm2 + w0 * xm3;
                    XC[(rg * 32 + r) * 132 + ch] = xc; At[(rg * 32 + r) * 136 + ch] = (bf16)f2bf(xc); xm3 = xm2; xm2 = xm1; xm1 = x0; }
                const gf o = out + OUT_CVS + ((size_t)l * DECB + nb) * 3 * DLRU + ch0 + ch; o[0] = xm3; o[DLRU] = xm2; o[2 * DLRU] = xm1; }
        }
    }
    const int fr = lane & 15, fq = lane >> 4;
    pg8::f32x4 acc_a[8], acc_i[8];
#pragma unroll
    for (int ct = 0; ct < 8; ++ct) { acc_a[ct] = (pg8::f32x4){0.f, 0.f, 0.f, 0.f}; acc_i[ct] = (pg8::f32x4){0.f, 0.f, 0.f, 0.f}; }
    {
#pragma unroll
        for (int j = 0; j < 4; ++j) { const int q = tid + 512 * j; *(LAS v4u*)(Wt + (q >> 4) * 136 + (q & 15) * 8) = wa_r[j]; }
    }
    LDS_WAIT(); __syncthreads();
    bf16x8 af[4];
#pragma unroll
    for (int ks = 0; ks < 4; ++ks) af[ks] = *(const LAS bf16x8*)(At + (wave * 16 + fr) * 136 + ks * 32 + fq * 8);
#pragma unroll
    for (int ct = 0; ct < 8; ++ct)
#pragma unroll
        for (int ks = 0; ks < 4; ++ks) { const bf16x8 bfr = *(const LAS bf16x8*)(Wt + (ct * 16 + fr) * 136 + ks * 32 + fq * 8); acc_a[ct] = __builtin_amdgcn_mfma_f32_16x16x32_bf16(bfr, af[ks], acc_a[ct], 0, 0, 0); }
    LDS_WAIT(); __syncthreads();
    {
#pragma unroll
        for (int j = 0; j < 4; ++j) { const int q = tid + 512 * j; *(LAS v4u*)(Wt + (q >> 4) * 136 + (q & 15) * 8) = wi_r[j]; }
    }
    LDS_WAIT(); __syncthreads();
#pragma unroll
    for (int ct = 0; ct < 8; ++ct)
#pragma unroll
        for (int ks = 0; ks < 4; ++ks) { const bf16x8 bfr = *(const LAS bf16x8*)(Wt + (ct * 16 + fr) * 136 + ks * 32 + fq * 8); acc_i[ct] = __builtin_amdgcn_mfma_f32_16x16x32_bf16(bfr, af[ks], acc_i[ct], 0, 0, 0); }
    LDS_WAIT(); __syncthreads();
    {
        const int row = wave * 16 + fr;
#pragma unroll
        for (int ct = 0; ct < 8; ++ct) { const int c4 = ct * 16 + fq * 4;
            const pg8::f32x4 bav = *(const LAS pg8::f32x4*)(PAR + c4), biv = *(const LAS pg8::f32x4*)(PAR + 128 + c4), clv = *(const LAS pg8::f32x4*)(PAR + 256 + c4);
            const pg8::f32x4 xcv = *(const LAS pg8::f32x4*)(XC + row * 132 + c4); pg8::f32x4 av, bv;
#pragma unroll
            for (int j = 0; j < 4; ++j) { const float r = pg8::fast_sigmoid(acc_a[ct][j] + bav[j]), ig = pg8::fast_sigmoid(acc_i[ct][j] + biv[j]);
                const float la = clv[j] * r; const float a = __builtin_amdgcn_exp2f(1.44269504089f * la); av[j] = a;
                const float z = 2.0f * la; const float om = (z > -0.0625f) ? -z * (1.0f + z * (0.5f + z * (0.16666667f + z * 0.041666668f))) : (1.0f - a * a);
                bv[j] = __builtin_amdgcn_sqrtf(om) * (ig * xcv[j]); }
            *(LAS pg8::f32x4*)(AA + row * 132 + c4) = av; *(LAS pg8::f32x4*)(XC + row * 132 + c4) = bv; }
    }
    LDS_WAIT(); __syncthreads();
    if constexpr (!SAMPLE) {
        float hh = 0.f, pp = 1.f;
#pragma unroll 8
        for (int r = 0; r < 32; ++r) { const float a = AA[(rg * 32 + r) * 132 + ch], b = XC[(rg * 32 + r) * 132 + ch]; hh = a * hh + b; pp *= a; }
        SEG[tid * 2] = pp; SEG[tid * 2 + 1] = hh;
        LDS_WAIT(); __syncthreads();
        unsigned short gv[32];
        { const cgb GLp = (cgb)(ws + WS_GL) + (size_t)(row0 + rg * 32) * DLRU + ch0 + ch;
#pragma unroll
          for (int r = 0; r < 32; ++r) gv[r] = GLp[(size_t)r * DLRU]; }
        const int uidx = ((n * 8 + h) << 4) + cidx;
        GAS unsigned long long* cs = (GAS unsigned long long*)(ws + WS_CS) + ((size_t)l * 512 + uidx) * 128;
        gu32* flg = (gu32*)(ws + WS_CTL) + CW_LRUF + (l * 512 + ((n * 8 + h) << 4)) * 16;
        if (rg == 3) { float P = 1.f, Hh = 0.f;
#pragma unroll
            for (int sg = 0; sg < 4; ++sg) { const float ps = SEG[(sg * 128 + ch) * 2], hs = SEG[(sg * 128 + ch) * 2 + 1]; Hh = ps * Hh + hs; P *= ps; }
            __hip_atomic_store(cs + ch, ((unsigned long long)__float_as_uint(Hh) << 32) | (unsigned long long)__float_as_uint(P), RLX_AGENT); }
        VM_WAIT(); __syncthreads();
        if (tid == 0) __hip_atomic_store(flg + 16 * cidx, 1u, RLX_AGENT);
        if (cidx > 0) {
            if (wave == 0) { unsigned spins = 0;
                for (;;) { bool ok = true; if (lane < cidx) ok = __hip_atomic_load(flg + 16 * lane, RLX_AGENT) != 0u;
                    if (__all(ok)) break; __builtin_amdgcn_s_sleep(2); if (++spins > (1u << 20)) break; }
                __builtin_amdgcn_fence(__ATOMIC_ACQUIRE, "agent"); VM_WAIT(); }
            __syncthreads();
        }
        hh = 0.f;
        for (int j = 0; j < cidx; ++j) { const unsigned long long v = __hip_atomic_load(cs - (size_t)(cidx - j) * 128 + ch, RLX_AGENT); hh = __uint_as_float((unsigned)v) * hh + __uint_as_float((unsigned)(v >> 32)); }
        for (int sg = 0; sg < rg; ++sg) { const float ps = SEG[(sg * 128 + ch) * 2], hs = SEG[(sg * 128 + ch) * 2 + 1]; hh = ps * hh + hs; }
        {
            const gb Y = (gb)(ws + WS_YMIX) + (size_t)(row0 + rg * 32) * DM + ch0 + ch;
#pragma unroll
            for (int r = 0; r < 32; ++r) { const float a = AA[(rg * 32 + r) * 132 + ch], b = XC[(rg * 32 + r) * 132 + ch]; hh = a * hh + b; Y[(size_t)r * DM] = (bf16)f2bf(hh * bf2f(gv[r])); }
            if (cidx == 15 && rg == 3) out[OUT_HP + ((size_t)l * NB + n) * DLRU + ch0 + ch] = hh;
        }
    } else {
        const cgb GLp = (cgb)(ws + WS_GL); const gb YMIX = (gb)(ws + WS_YMIX);
#pragma unroll 2
        for (int e = 0; e < 8; ++e) { const int nb = blk * 32 + rg * 8 + e; float hh = TIN(6)[((size_t)l * DECB + nb) * DLRU + ch0 + ch];
#pragma unroll
            for (int t = 0; t < 4; ++t) { const int r = rg * 32 + e * 4 + t; const float a = AA[r * 132 + ch], b = XC[r * 132 + ch]; hh = a * hh + b;
                const size_t m = (size_t)(row0 + r); const float g = bf2f(GLp[m * DLRU + ch0 + ch]); YMIX[m * DM + ch0 + ch] = (bf16)f2bf(hh * g); }
            out[OUT_HS + ((size_t)l * DECB + nb) * DLRU + ch0 + ch] = hh; }
    }
    LDS_WAIT(); __syncthreads();
}

constexpr int SG_A = 0;
constexpr int SG_B = 34816;
constexpr int SG_ST = 69632;

__device__ __forceinline__ void sgu_unit(LAS unsigned char* lds, int l, int ui, int tid, int wave, int lane) {
    const int g = ui & 7, cidx = (ui >> 3) & 15, n = ui >> 7; const int row0 = n * SEQ + cidx * 128, col0 = g * 128;
    LAS bf16* At = (LAS bf16*)(lds + SG_A); LAS bf16* Bt = (LAS bf16*)(lds + SG_B); LAS float* ST = (LAS float*)(lds + SG_ST);
    const gu8 ws = TWS();
    v2u ur[8];
    { const cgb UGp = (cgb)(ws + WS_UG) + (size_t)(row0 + wave * 16 + (lane & 15)) * DSGU + col0 + (lane >> 4) * 4;
#pragma unroll
      for (int ct = 0; ct < 8; ++ct) ur[ct] = *(const GAS v2u*)(UGp + ct * 16); }
    if (tid < 128) { const GAS f32x4* p = (const GAS f32x4*)((cgf)(ws + WS_VST) + (size_t)(row0 + tid) * 32); float s = 0.f, q = 0.f;
#pragma unroll
        for (int j = 0; j < 8; ++j) { const f32x4 v = p[j]; s += v.x + v.z; q += v.y + v.w; }
        const float mean = s * (1.f / DSGU); const float var = fmaxf(q * (1.f / DSGU) - mean * mean, 0.f); ST[tid * 2] = mean; ST[tid * 2 + 1] = 1.0f / sqrtf(var + EPS); }
    {
        const GAS v4u* src = (const GAS v4u*)(ws + WS_W + (size_t)l * WL_SIZE + WL_SGW + (size_t)g * 32768);
#pragma unroll
        for (int j = 0; j < 4; ++j) { const int q = tid + 512 * j; *(LAS v4u*)(At + (q >> 4) * 136 + (q & 15) * 8) = src[q]; }
    }
    LDS_WAIT(); __syncthreads();
    {
        const int s = tid >> 2, dq = tid & 3; const float mean = ST[s * 2], rstd = ST[s * 2 + 1];
        const GAS f32x4* vp = (const GAS f32x4*)((cgf)(ws + WS_VG) + (size_t)(row0 + s) * DSGU + col0 + dq * 32);
        const GAS f32x4* gp = (const GAS f32x4*)(TIN(19) + ((size_t)l * 2 + 0) * DSGU + col0 + dq * 32); const GAS f32x4* bp = (const GAS f32x4*)(TIN(19) + ((size_t)l * 2 + 1) * DSGU + col0 + dq * 32);
#pragma unroll
        for (int jj = 0; jj < 8; ++jj) { const f32x4 v = vp[jj], gg = gp[jj], bb = bp[jj];
#pragma unroll
            for (int e = 0; e < 4; ++e) Bt[(dq * 32 + jj * 4 + e) * 136 + s] = (bf16)f2bf((v[e] - mean) * rstd * gg[e] + bb[e]); }
    }
    LDS_WAIT(); __syncthreads();
    const int fr = lane & 15, fq = lane >> 4;
    pg8::f32x4 acc[8];
#pragma unroll
    for (int ct = 0; ct < 8; ++ct) acc[ct] = (pg8::f32x4){0.f, 0.f, 0.f, 0.f};
    bf16x8 af[4];
#pragma unroll
    for (int ks = 0; ks < 4; ++ks) af[ks] = *(const LAS bf16x8*)(At + (wave * 16 + fr) * 136 + ks * 32 + fq * 8);
#pragma unroll
    for (int ct = 0; ct < 8; ++ct)
#pragma unroll
        for (int ks = 0; ks < 4; ++ks) { const bf16x8 bfr = *(const LAS bf16x8*)(Bt + (ct * 16 + fr) * 136 + ks * 32 + fq * 8); acc[ct] = __builtin_amdgcn_mfma_f32_16x16x32_bf16(bfr, af[ks], acc[ct], 0, 0, 0); }
    {
        const int t = wave * 16 + fr; const float bias = TIN(21)[((size_t)l * 8 + g) * CHUNK + t]; const size_t m = (size_t)(row0 + t);
        const gb YMIX = (gb)(ws + WS_YMIX);
#pragma unroll
        for (int ct = 0; ct < 8; ++ct) { const int d = ct * 16 + fq * 4; const v2u uw = ur[ct];
            v2u o; o.x = pg8::cvt_pk_bf16(bflo(uw.x) * (acc[ct][0] + bias), bfhi(uw.x) * (acc[ct][1] + bias)); o.y = pg8::cvt_pk_bf16(bflo(uw.y) * (acc[ct][2] + bias), bfhi(uw.y) * (acc[ct][3] + bias));
            *(GAS v2u*)(YMIX + m * DM + DLRU + col0 + d) = o; }
    }
    LDS_WAIT(); __syncthreads();
}
__device__ __forceinline__ void sgu_sample_item(LAS unsigned char* lds, int l, int nb, int lane) {
    float vn[4][16];
    const int cbase = lane * 16;
    const gu8 ws = TWS(); const gf out = TOUT();
    const cgf lng = TIN(19) + ((size_t)l * 2 + 0) * DSGU + cbase; const cgf lnb = TIN(19) + ((size_t)l * 2 + 1) * DSGU + cbase;
#pragma unroll
    for (int t = 0; t < 4; ++t) { const size_t m = (size_t)(MP + nb * 4 + t);
        const GAS f32x4* vp = (const GAS f32x4*)((cgf)(ws + WS_VG) + m * DSGU + cbase); const GAS f32x4* gp = (const GAS f32x4*)lng; const GAS f32x4* bp = (const GAS f32x4*)lnb;
        f32x4 v[4]; float sm = 0.f;
#pragma unroll
        for (int j = 0; j < 4; ++j) { v[j] = vp[j]; sm += (v[j].x + v[j].y) + (v[j].z + v[j].w); }
        const float mean = wave_sum(sm) * (1.f / DSGU); float sq = 0.f;
#pragma unroll
        for (int j = 0; j < 4; ++j)
#pragma unroll
            for (int e = 0; e < 4; ++e) { const float d = v[j][e] - mean; sq += d * d; }
        const float rstd = 1.0f / sqrtf(wave_sum(sq) * (1.f / DSGU) + EPS);
        GAS f32x4* op = (GAS f32x4*)(out + OUT_VS + (((size_t)l * DECB + nb) * 4 + t) * DSGU + cbase);
#pragma unroll
        for (int j = 0; j < 4; ++j) { const f32x4 gg = gp[j], bb = bp[j]; f32x4 o;
#pragma unroll
            for (int e = 0; e < 4; ++e) { o[e] = (v[j][e] - mean) * rstd * gg[e] + bb[e]; vn[t][j * 4 + e] = o[e]; }
            op[j] = o; } }
    const int g = cbase >> 7;
    const cgf sgw = TIN(20) + ((size_t)l * 8 + g) * 16384; const cgf sgb = TIN(21) + ((size_t)l * 8 + g) * CHUNK;
#pragma unroll
    for (int t = 0; t < 4; ++t) { const size_t m = (size_t)(MP + nb * 4 + t); const float bias = sgb[t];
        float w[4];
#pragma unroll
        for (int s = 0; s < 4; ++s) w[s] = (s <= t) ? sgw[t * 128 + s] : 0.f;
        const GAS v4u* up = (const GAS v4u*)((cgb)(ws + WS_UG) + m * DSGU + cbase); GAS v4u* yp = (GAS v4u*)((gb)(ws + WS_YMIX) + m * DM + DLRU + cbase);
#pragma unroll
        for (int j = 0; j < 2; ++j) { const v4u uw = up[j]; float sv[8];
#pragma unroll
            for (int e = 0; e < 8; ++e) { float acc = bias;
#pragma unroll
                for (int s = 0; s < 4; ++s) acc += w[s] * vn[s][j * 8 + e];
                sv[e] = acc; }
            v4u o; o.x = pk2(bflo(uw.x) * sv[0], bfhi(uw.x) * sv[1]); o.y = pk2(bflo(uw.y) * sv[2], bfhi(uw.y) * sv[3]); o.z = pk2(bflo(uw.z) * sv[4], bfhi(uw.z) * sv[5]); o.w = pk2(bflo(uw.w) * sv[6], bfhi(uw.w) * sv[7]);
            yp[j] = o; } }
}

__device__ __forceinline__ void lru_fix_unit(LAS unsigned char* lds, int l, int ui, int wave, int lane) {
    const int qd = ui & 3, cidx = (ui >> 2) & 15, n = ui >> 6; const int cch = qd * 256 + lane * 4;
    const gu8 ws = TWS();
    const cgf HLOC = (cgf)(ws + WS_HLOC), PC = (cgf)(ws + WS_PC), CSUM = (cgf)(ws + WS_CSUM); const cgb GLp = (cgb)(ws + WS_GL); const gb YMIX = (gb)(ws + WS_YMIX);
    f32x4 H = (f32x4){0.f, 0.f, 0.f, 0.f};
    for (int j = 0; j < cidx; ++j) { const GAS f32x4* cs = (const GAS f32x4*)(CSUM + ((size_t)(n * 16 + j) * DLRU + cch) * 2); const f32x4 c0 = cs[0], c1 = cs[1];
        H.x = c0.x * H.x + c0.y; H.y = c0.z * H.y + c0.w; H.z = c1.x * H.z + c1.y; H.w = c1.z * H.w + c1.w; }
#pragma unroll 4
    for (int r = 0; r < 16; ++r) { const int t = cidx * 128 + wave * 16 + r; const size_t m = (size_t)(n * SEQ + t);
        const f32x4 hl = *(const GAS f32x4*)(HLOC + m * DLRU + cch), pc = *(const GAS f32x4*)(PC + m * DLRU + cch); const v2u gw = *(const GAS v2u*)(GLp + m * DLRU + cch);
        const f32x4 hv = hl + pc * H;
        v2u o; o.x = pk2(hv.x * bflo(gw.x), hv.y * bfhi(gw.x)); o.y = pk2(hv.z * bflo(gw.y), hv.w * bfhi(gw.y));
        *(GAS v2u*)(YMIX + m * DM + cch) = o;
        if (t == SEQ - 1) *(GAS f32x4*)(TOUT() + OUT_HP + ((size_t)l * NB + n) * DLRU + cch) = hv; }
}

constexpr int SA_SC = 0;
constexpr int SA_O = 4096;
__device__ __forceinline__ void sattn_unit(LAS unsigned char* lds, int l, int ui, int tid, int wave, int lane) {
    const int h = ui & 3, nb = ui >> 2;
    LAS float* SC = (LAS float*)(lds + SA_SC); LAS float* OA = (LAS float*)(lds + SA_O);
    const gu8 ws = TWS();
    const cgf kbase = TIN(3) + (((size_t)l * DECB + nb) * MEML * XAH + h) * XAD + lane * 8;
    {
        float q[4][8];
#pragma unroll
        for (int t = 0; t < 4; ++t) { const v4u w = *(const GAS v4u*)((cgb)(ws + WS_QB) + (size_t)(MP + nb * 4 + t) * DM + h * XAD + lane * 8);
            q[t][0] = bflo(w.x); q[t][1] = bfhi(w.x); q[t][2] = bflo(w.y); q[t][3] = bfhi(w.y); q[t][4] = bflo(w.z); q[t][5] = bfhi(w.z); q[t][6] = bflo(w.w); q[t][7] = bfhi(w.w); }
#pragma unroll 1
        for (int kb = 0; kb < 4; ++kb) {
            const int key0 = wave * 32 + kb * 8;
            f32x4 kv[8][2];
#pragma unroll
            for (int j = 0; j < 8; ++j) { const GAS f32x4* kp = (const GAS f32x4*)(kbase + (size_t)(key0 + j) * (XAH * XAD)); kv[j][0] = kp[0]; kv[j][1] = kp[1]; }
            float v[32];
#pragma unroll
            for (int j = 0; j < 8; ++j)
#pragma unroll
                for (int t = 0; t < 4; ++t) { v[j * 4 + t] = (q[t][0] * kv[j][0].x + q[t][1] * kv[j][0].y) + (q[t][2] * kv[j][0].z + q[t][3] * kv[j][0].w) + (q[t][4] * kv[j][1].x + q[t][5] * kv[j][1].y) + (q[t][6] * kv[j][1].z + q[t][7] * kv[j][1].w); }
#pragma unroll
            for (int j = 0; j < 32; ++j) v[j] += pg8::shx(v[j], 32);
#pragma unroll
            for (int s = 0; s < 5; ++s) { const int off = 16 >> s; const bool up = (lane & off) != 0;
#pragma unroll
                for (int j = 0; j < (16 >> s); ++j) { const float keep = up ? v[j + off] : v[j]; const float send = up ? v[j] : v[j + off]; v[j] = keep + pg8::shx(send, off); } }
            if (lane < 32) SC[(lane & 3) * 256 + key0 + (lane >> 2)] = v[0];
        }
    }
    LDS_WAIT(); __syncthreads();
    if (wave < 4) { const float sl2 = 0.04419417382f * 1.44269504089f; f32x4 s = *(const LAS f32x4*)(SC + wave * 256 + lane * 4);
        const float mx = wave_max(fmaxf(fmaxf(s.x, s.y), fmaxf(s.z, s.w))) * sl2;
        s.x = __builtin_amdgcn_exp2f(s.x * sl2 - mx); s.y = __builtin_amdgcn_exp2f(s.y * sl2 - mx); s.z = __builtin_amdgcn_exp2f(s.z * sl2 - mx); s.w = __builtin_amdgcn_exp2f(s.w * sl2 - mx);
        const float inv = 1.0f / wave_sum((s.x + s.y) + (s.z + s.w));
        *(LAS f32x4*)(SC + wave * 256 + lane * 4) = s * inv; }
    LDS_WAIT(); __syncthreads();
    {
        const cgf vbase = TIN(4) + (((size_t)l * DECB + nb) * MEML * XAH + h) * XAD + lane * 8;
        float o[4][8];
#pragma unroll
        for (int t = 0; t < 4; ++t)
#pragma unroll
            for (int e = 0; e < 8; ++e) o[t][e] = 0.f;
#pragma unroll 1
        for (int kb = 0; kb < 4; ++kb) {
            const int key0 = wave * 32 + kb * 8;
            f32x4 vv[8][2];
#pragma unroll
            for (int j = 0; j < 8; ++j) { const GAS f32x4* vp = (const GAS f32x4*)(vbase + (size_t)(key0 + j) * (XAH * XAD)); vv[j][0] = vp[0]; vv[j][1] = vp[1]; }
#pragma unroll
            for (int j = 0; j < 8; ++j)
#pragma unroll
                for (int t = 0; t < 4; ++t) { const float p = SC[t * 256 + key0 + j];
                    o[t][0] += p * vv[j][0].x; o[t][1] += p * vv[j][0].y; o[t][2] += p * vv[j][0].z; o[t][3] += p * vv[j][0].w; o[t][4] += p * vv[j][1].x; o[t][5] += p * vv[j][1].y; o[t][6] += p * vv[j][1].z; o[t][7] += p * vv[j][1].w; }
        }
#pragma unroll
        for (int t = 0; t < 4; ++t) { *(LAS f32x4*)(OA + (wave * 4 + t) * 512 + lane * 8) = (f32x4){o[t][0], o[t][1], o[t][2], o[t][3]}; *(LAS f32x4*)(OA + (wave * 4 + t) * 512 + lane * 8 + 4) = (f32x4){o[t][4], o[t][5], o[t][6], o[t][7]}; }
    }
    LDS_WAIT(); __syncthreads();
    {
        const int t = tid >> 7, d = (tid & 127) * 4; f32x4 s = (f32x4){0.f, 0.f, 0.f, 0.f};
#pragma unroll
        for (int w = 0; w < 8; ++w) s = s + *(const LAS f32x4*)(OA + (w * 4 + t) * 512 + d);
        v2u ov; ov.x = pk2(s.x, s.y); ov.y = pk2(s.z, s.w);
        *(GAS v2u*)((gb)(ws + WS_OB) + (size_t)(MP + nb * 4 + t) * DM + h * XAD + d) = ov;
    }
    LDS_WAIT(); __syncthreads();
}

constexpr int NPHASES = 1 + 16 * DEPTH;

__global__ void __launch_bounds__(NWAVES * 64, 2) fwd(Args args) {
    extern __shared__ __attribute__((aligned(16))) unsigned char lds_raw[];
    LAS unsigned char* lds = (LAS unsigned char*)lds_raw;
    volatile LAS unsigned* MISC = (volatile LAS unsigned*)(lds + MISC_OFF);
    const int G = gridDim.x, bx = blockIdx.x;
    const int wave_s = __builtin_amdgcn_readfirstlane((int)(threadIdx.x >> 6));
#define PHASE_IDS() int tid = wave_s * 64 + pg8::lane_id(); asm volatile("" : "+v"(tid)); const int lane = tid & 63, wave = __builtin_amdgcn_readfirstlane(tid >> 6); \
    const int vcu = (G % 8 == 0) ? (bx % 8) * (G / 8) + bx / 8 : bx; const int gw = vcu * NWAVES + wave, NGW = G * NWAVES; (void)lane; (void)gw; (void)NGW
    for (int u = threadIdx.x; u < 64; u += NWAVES * 64) ((LAS unsigned*)(lds + MISC_OFF))[u] = 0u;
    if (threadIdx.x == 0) { LAS unsigned long long* TAB = (LAS unsigned long long*)(lds + TAB_OFF);
#pragma unroll
        for (int i = 0; i < 30; ++i) TAB[i] = (unsigned long long)args.in[i];
        TAB[30] = (unsigned long long)args.out; TAB[31] = (unsigned long long)args.ws; }
    __syncthreads();
#if !MK_PER_PHASE
    (void)xcd_barrier_post((GAS unsigned*)(args.ws + WS_CTL) + CW_BAR, MISC + 8, threadIdx.x == 0);
#define GRID_BAR() do { XcdBarrier b_; const unsigned long long bp_ = tab_ld(lds, 31) + WS_CTL + 4ull * CW_BAR; unsigned blo_ = (unsigned)bp_, bhi_ = (unsigned)(bp_ >> 32); unsigned x_ = __builtin_amdgcn_readfirstlane(xb_xcc_id()), st_ = __builtin_amdgcn_readfirstlane((unsigned)(size_t)(LAS unsigned*)(lds + MISC_OFF + 32)); asm volatile("" : "+s"(blo_), "+s"(bhi_), "+s"(x_), "+s"(st_)); b_.bar = (GAS unsigned*)(((unsigned long long)bhi_ << 32) | blo_); b_.x = x_; b_.st = (volatile LAS unsigned*)(size_t)st_; xcd_barrier(b_, wave_s == 0 && pg8::lane_id() == 0); } while (0)
#else
#define GRID_BAR() do {} while (0)
#endif
    const int lo = args.ph_lo, hi = args.ph_hi;
#define IN(k) (lo <= (k) && (k) < hi)
#define SEAM(k) do { if (IN(k) && IN((k) + 1)) GRID_BAR(); } while (0)

    if (PHT(16) && IN(0)) { PHASE_IDS();
        const gu8 ws = TWS();
        LAS float* scr = (LAS float*)(lds + wave * 16384);
        constexpr int I_FIN = (DM / 64) * (2 * DFF / 32), I_FDN = (DFF / 64) * (DM / 32), I_WIN = (DM / 64) * (4096 / 32), I_SQ = (DM / 64) * (DM / 32), I_LR = 8 * 2 * 4;
        constexpr int I_LAYER = 2 * I_FIN + 2 * I_FDN + 2 * I_WIN + 3 * I_SQ + 2 * I_LR;
        for (int it = gw; it < DEPTH * I_LAYER; it += NGW) {
            const int l = it / I_LAYER; int r = it - l * I_LAYER;
            const gu8 wl = ws + WS_W + (size_t)l * WL_SIZE;
            if (r < I_FIN) { p0_mat_ffn_in(TIN(8) + (size_t)l * DM * 2 * DFF, (gb)(wl + WL_FIN1), r, scr, lane, TIN(7) + ((size_t)l * 2 + 0) * DM); continue; } r -= I_FIN;
            if (r < I_FIN) { p0_mat_ffn_in(TIN(28) + (size_t)l * DM * 2 * DFF, (gb)(wl + WL_FIN2), r, scr, lane, TIN(27) + ((size_t)l * 2 + 0) * DM); continue; } r -= I_FIN;
            if (r < I_FDN) { p0_mat(TIN(9) + (size_t)l * DFF * DM, DFF, DM, (gb)(wl + WL_FDN1), r, scr, lane); continue; } r -= I_FDN;
            if (r < I_FDN) { p0_mat(TIN(29) + (size_t)l * DFF * DM, DFF, DM, (gb)(wl + WL_FDN2), r, scr, lane); continue; } r -= I_FDN;
            if (r < I_WIN) { p0_mat(TIN(11) + (size_t)l * DM * 4096, DM, 4096, (gb)(wl + WL_WIN), r, scr, lane, TIN(10) + ((size_t)l * 2 + 0) * DM); continue; } r -= I_WIN;
            if (r < I_WIN) { p0_mat(TIN(25) + (size_t)l * DM * 4096, DM, 4096, (gb)(wl + WL_WKV), r, scr, lane); continue; } r -= I_WIN;
            if (r < I_SQ) { p0_mat(TIN(22) + (size_t)l * DM * DM, DM, DM, (gb)(wl + WL_WOUT), r, scr, lane); continue; } r -= I_SQ;
            if (r < I_SQ) { p0_mat(TIN(24) + (size_t)l * DM * DM, DM, DM, (gb)(wl + WL_WQ), r, scr, lane, TIN(23) + ((size_t)l * 3 + 0) * DM); continue; } r -= I_SQ;
            if (r < I_SQ) { p0_mat(TIN(26) + (size_t)l * DM * DM, DM, DM, (gb)(wl + WL_WO), r, scr, lane); continue; } r -= I_SQ;
            if (r < I_LR) { const int hh = r >> 3; p0_mat(TIN(14) + ((size_t)l * 8 + hh) * 16384, 128, 128, (gb)(wl + WL_LRA) + (size_t)hh * 16384, r & 7, scr, lane); continue; } r -= I_LR;
            { const int hh = r >> 3; p0_mat(TIN(16) + ((size_t)l * 8 + hh) * 16384, 128, 128, (gb)(wl + WL_LRI) + (size_t)hh * 16384, r & 7, scr, lane); }
        }
        { const cgf sgw = TIN(20);
        for (int i = gw * 64 + lane; i < DEPTH * 8 * 128 * 128 / 4; i += NGW * 64) { const int e = i * 4; const int l = e >> 17, rem = e & 131071, t = (rem >> 7) & 127, s0 = rem & 127;
            const f32x4 w = *(const GAS f32x4*)(sgw + e);
            v2u o; o.x = pk2(s0 <= t ? w.x : 0.f, s0 + 1 <= t ? w.y : 0.f); o.y = pk2(s0 + 2 <= t ? w.z : 0.f, s0 + 3 <= t ? w.w : 0.f);
            *(GAS v2u*)((gb)(ws + WS_W + (size_t)l * WL_SIZE + WL_SGW) + rem) = o; } }
        { const cgf mem = TIN(2); const cgf xan = TIN(23);
        for (int m = gw; m < DEPTH * MMEM; m += NGW) { const int l = m / MMEM, r = m % MMEM; rms_row_to_bf16(mem + (size_t)r * DM, xan + ((size_t)l * 3 + 2) * DM, (gb)(ws + WS_MEMN) + (size_t)m * DM, lane); } }
        { const cgf xp = TIN(0); const cgf xs = TIN(1);
        for (int m = gw; m < MT; m += NGW) { const cgf xr = (m < MP) ? xp + (size_t)m * DM : xs + (size_t)(m - MP) * DM; x_row_init(xr, (gb)(ws + WS_HB) + (size_t)m * DM, (gf)(ws + WS_RS) + (size_t)m * 8, lane); } }
    }
    SEAM(0);

    for (int l = 0; l < DEPTH; ++l) {
        const int pb = 1 + 16 * l;
#define FFN_IN_PHASE(ph, WOFF, WITHKV) if (PHT(0) && IN(ph)) { const gu8 ws = TWS(); const gf out = TOUT(); \
            SchedFfnIn S{(cgc)(ws + WS_HB), (cgc)(ws + WS_W + (size_t)l * WL_SIZE + (WOFF)), (cgc)(ws + WS_MEMN + (size_t)l * MMEM * DM * 2), (cgc)(ws + WS_W + (size_t)l * WL_SIZE + WL_WKV), G, bx, (WITHKV)}; \
            pg8::EpiFfnIn E{(gb)(ws + WS_ACT), DFF, out + OUT_MK + (size_t)l * MMEM * DM, (gb)(ws + WS_KB), out + OUT_MV + (size_t)l * MMEM * DM, (gb)(ws + WS_VT), (cgf)(ws + WS_RS)}; \
            pg8::gemm_phase<pg8::EpiFfnIn, SchedFfnIn, true, true, false, true>(lds, wave_s, DM, DM, S, E); } SEAM(ph);
#define TG_PHASE(ph, PHT_ID, AOFF, WOFF, KK, KINST, G1, CC) if (PHT(PHT_ID) && IN(ph)) { const gu8 ws = TWS(); const int inst = l * 4 + (KINST); \
            SchedStrip<false> S{(cgc)(ws + (AOFF)), (cgc)(ws + WS_W + (size_t)l * WL_SIZE + (WOFF)), (KK), (KK), DM / 256, (KK), G, bx}; \
            pg8::EpiT E{TIN(0), TIN(1), (gb)(ws + WS_HB), TOUT(), (G1), (CC), (gf)(ws + WS_TXB) + (size_t)inst * 32 * 272 * 8, (GAS unsigned*)(ws + WS_CTL) + CW_TC + inst * 512, (gf)(ws + WS_RS), \
                        (inst == 0) ? 1 : ((inst == 4 * DEPTH - 1) ? 2 : 0)}; \
            pg8::gemm_phase<pg8::EpiT, SchedStrip<false>, false, true, true, KOUT_T>(lds, wave_s, (KK), (KK), S, E); } SEAM(ph);
        FFN_IN_PHASE(pb + 0, WL_FIN1, 1)
        TG_PHASE(pb + 1, 1, WS_ACT, WL_FDN1, DFF, 0, TIN(7) + ((size_t)l * 2 + 1) * DM, 0.5f)

        if (PHT(3) && IN(pb + 3)) { const gu8 ws = TWS();
            SchedStrip<true> S{(cgc)(ws + WS_HB), (cgc)(ws + WS_W + (size_t)l * WL_SIZE + WL_WIN), DM, DM, 16, DM, G, bx};
            pg8::EpiMixIn E{(gf)(ws + WS_XL), (gb)(ws + WS_GL), (gb)(ws + WS_UG), (gf)(ws + WS_VG), (gf)(ws + WS_VST), (gf)(ws + WS_SLAB), (cgf)(ws + WS_RS)};
            pg8::gemm_phase<pg8::EpiMixIn, SchedStrip<true>, true, true, true, KOUT_M>(lds, wave_s, DM, DM, S, E);
        }
        SEAM(pb + 3);

        if (PHT(4) && IN(pb + 4)) { PHASE_IDS();
            constexpr int NU_LP = NB * 16 * 8, NU_LS = (MS / 128) * 8, NU_SS = DECB / NWAVES, NU_SG = NB * 16 * 8; static_assert(DECB % NWAVES == 0, "sample SGU items per queue item");
            for (int u = bx; u < NU_LP; u += G) lru_unit<false>(lds, l, u, tid, wave, lane);
            {
                gu32* qc = (gu32*)(TWS() + WS_CTL) + CW_QC + l * 64;
                for (;;) {
                    if (tid == 0) MISC[16] = __hip_atomic_fetch_add(qc, 1u, RLX_AGENT);
                    __syncthreads(); const int it = __builtin_amdgcn_readfirstlane((int)MISC[16]); __syncthreads();
                    if (it >= NU_LS + NU_SS + NU_SG) break;
                    if (it < NU_LS) lru_unit<true>(lds, l, it, tid, wave, lane);
                    else if (it < NU_LS + NU_SS) sgu_sample_item(lds, l, (it - NU_LS) * NWAVES + wave, lane);
                    else sgu_unit(lds, l, it - NU_LS - NU_SS, tid, wave, lane);
                }
            }
        }
        SEAM(pb + 4);

        TG_PHASE(pb + 6, 6, WS_YMIX, WL_WOUT, DM, 1, TIN(10) + ((size_t)l * 2 + 1) * DM, 1.0f)

        if (PHT(8) && IN(pb + 8)) { const gu8 ws = TWS();
            SchedStrip<false> S{(cgc)(ws + WS_HB), (cgc)(ws + WS_W + (size_t)l * WL_SIZE + WL_WQ), DM, DM, DM / 256, DM, G, bx};
            pg8::EpiQ E{(gb)(ws + WS_QB), (gf)(ws + WS_SLAB), (cgf)(ws + WS_RS), MP};
            pg8::gemm_phase<pg8::EpiQ, SchedStrip<false>, true, true, true, KOUT_Q>(lds, wave_s, DM, DM, S, E);
        }
        SEAM(pb + 8);

        const bool fuse_pv = (G >= NB * XAH * 8 * 2);
        if (PHT(9) && IN(pb + 9)) {
            gu32* xf = (gu32*)(TWS() + WS_CTL) + CW_XF + l * (NB * XAH * 8) * 16;
            { const gu8 ws = TWS();
            SchedX1 S{(cgc)(ws + WS_QB), (cgc)(ws + WS_KB), G, bx};
            pg8::EpiSoftmax E{(gb)(ws + WS_PB), 1024, 0.04419417382f * 1.44269504089f};
            pg8::gemm_phase<pg8::EpiSoftmax, SchedX1, false, true>(lds, wave_s, DM, DM, S, E); }
            VM_WAIT(); __syncthreads(); PHASE_IDS();
            if (fuse_pv && bx < NB * XAH * 8 && tid == 0) {
                __builtin_amdgcn_fence(__ATOMIC_RELEASE, "agent"); VM_WAIT();
                __hip_atomic_store(xf + 16 * bx, 1u, RLX_AGENT); }
            for (int u = bx; u < DECB * XAH; u += G) sattn_unit(lds, l, u, tid, wave, lane);
            if (fuse_pv && bx >= NB * XAH * 8 && bx < NB * XAH * 8 * 2) {
                const int cc = bx - NB * XAH * 8;
                if (wave == 0) { unsigned spins = 0;
                    while ((unsigned)__builtin_amdgcn_readfirstlane((int)__hip_atomic_load(xf + 16 * cc, RLX_AGENT)) == 0u) { __builtin_amdgcn_s_sleep(1); if (++spins > (1u << 20)) break; }
                    __builtin_amdgcn_fence(__ATOMIC_ACQUIRE, "agent"); VM_WAIT(); }
                __syncthreads();
                const gu8 ws = TWS();
                SchedX2pair S{(cgc)(ws + WS_PB), (cgc)(ws + WS_VT), cc};
                pg8::EpiBf16 E{(gb)(ws + WS_OB), DM};
                pg8::gemm_phase<pg8::EpiBf16, SchedX2pair, true, true>(lds, wave_s, 1024, 1024, S, E);
            }
        }
        SEAM(pb + 9);

        if (!fuse_pv) {
        if (PHT(10) && IN(pb + 10)) { const gu8 ws = TWS();
            SchedX2 S{(cgc)(ws + WS_PB), (cgc)(ws + WS_VT), G, bx};
            pg8::EpiBf16 E{(gb)(ws + WS_OB), DM};
            pg8::gemm_phase<pg8::EpiBf16, SchedX2, true, true>(lds, wave_s, 1024, 1024, S, E);
        }
        SEAM(pb + 10);
        }

        TG_PHASE(pb + 11, 6, WS_OB, WL_WO, DM, 2, TIN(23) + ((size_t)l * 3 + 1) * DM, 1.0f)
        FFN_IN_PHASE(pb + 13, WL_FIN2, 0)
        TG_PHASE(pb + 14, 1, WS_ACT, WL_FDN2, DFF, 3, TIN(27) + ((size_t)l * 2 + 1) * DM, 0.5f)
    }
#undef IN
#undef SEAM
}

extern "C" void kernel_launch(void* const* d_in, const int* in_sizes, int n_in, void* d_out, int out_size, void* d_ws, size_t ws_size, hipStream_t stream) {
    static int grid = 0;
    if (grid == 0) {
        if (n_in != 30 || (size_t)out_size != OUT_END || ws_size < WS_END) { fprintf(stderr, "kernel_launch: built for 30 inputs, %zu outputs, >= %zu bytes of workspace; got n_in %d, out %d, ws %zu; nothing launched\n", (size_t)OUT_END, (size_t)WS_END, n_in, out_size, ws_size); grid = -1; return; }
        int dev = 0, cus = 0, per_cu = 0;
        if (hipGetDevice(&dev) != hipSuccess || hipDeviceGetAttribute(&cus, hipDeviceAttributeMultiprocessorCount, dev) != hipSuccess) { fprintf(stderr, "kernel_launch: device query failed\n"); grid = -1; return; }
        if (hipFuncSetAttribute((const void*)fwd, hipFuncAttributeMaxDynamicSharedMemorySize, LDS_BYTES) != hipSuccess) { fprintf(stderr, "kernel_launch: hipFuncSetAttribute failed\n"); grid = -1; return; }
        if (hipOccupancyMaxActiveBlocksPerMultiprocessor(&per_cu, (const void*)fwd, NWAVES * 64, LDS_BYTES) != hipSuccess || per_cu < 1) { fprintf(stderr, "kernel_launch: occupancy query reports %d\n", per_cu); }
        (void)hipGetLastError();
        grid = cus;
    }
    if (grid < 0) return;
    if (hipMemsetAsync((char*)d_ws + WS_CTL, 0, CTL_ZERO_BYTES, stream) != hipSuccess) { fprintf(stderr, "kernel_launch: memset failed\n"); return; }
    Args a{};
    for (int i = 0; i < 30; ++i) a.in[i] = (const float*)d_in[i];
    a.out = (float*)d_out; a.ws = (unsigned char*)d_ws;
#if MK_PER_PHASE
    for (int p = 0; p < NPHASES; ++p) { a.ph_lo = p; a.ph_hi = p + 1; hipLaunchKernelGGL(fwd, dim3(grid), dim3(NWAVES * 64), LDS_BYTES, stream, a); }
#else
    a.ph_lo = 0; a.ph_hi = NPHASES - 1;
    hipLaunchKernelGGL(fwd, dim3(grid), dim3(NWAVES * 64), LDS_BYTES, stream, a);
#endif
    const hipError_t le = hipPeekAtLastError();
    if (le != hipSuccess) fprintf(stderr, "kernel_launch: launch failed: %s\n", hipGetErrorName(le));
}
```

```cpp
#include <hip/hip_runtime.h>
#include <cstdio>
#include <cstdint>

#ifndef KOUT_T
#define KOUT_T true
#endif
#ifndef KOUT_Q
#define KOUT_Q true
#endif
#ifndef KOUT_M
#define KOUT_M true
#endif
#ifndef PH_ONLY
#define PH_ONLY (-1)
#endif
#define PHT(j) (PH_ONLY < 0 || PH_ONLY == (j))
#ifndef MK_PER_PHASE
#define MK_PER_PHASE 0
#endif

namespace pg8 {
#define PG8_LAS __attribute__((address_space(3)))
typedef unsigned short bf16_t;
typedef short bf16x8 __attribute__((ext_vector_type(8)));
typedef float f32x4 __attribute__((ext_vector_type(4)));
typedef float f32x2 __attribute__((ext_vector_type(2)));
typedef unsigned u32x4 __attribute__((ext_vector_type(4)));
typedef unsigned u32x2 __attribute__((ext_vector_type(2)));
constexpr int KIND_SLAB = 8;
constexpr int BM = 256, BK = 64, HALF = 128, HTB = HALF * BK * 2  , STAGE_BYTES = 8 * HTB, NXCD = 8, WGM = 4;

__host__ __device__ __forceinline__ int lds_byte(int r, int c) { const int st = (r >> 4) * 2 + (c >> 5), rr = r & 15, cc = c & 31, ob = rr * 64 + cc * 2; return st * 1024 + (ob ^ (((ob >> 9) & 1) << 5)); }
__host__ __device__ __forceinline__ void stage_rc(int b, int& R, int& C) { const int st = b / 1024, sb = b % 1024, swz = sb ^ (((sb >> 9) & 1) << 5); R = (st >> 1) * 16 + swz / 64; C = (st & 1) * 32 + (swz % 64) / 2; }
__host__ __device__ __forceinline__ int perm32(int rho) { const int n = rho >> 4, i = rho & 15; return 8 * (i >> 2) + 4 * n + (i & 3); }

#define PG8_GAS __attribute__((address_space(1)))
__device__ __forceinline__ int lane_id() { unsigned z = 0u; asm volatile("" : "+v"(z)); return (int)__builtin_amdgcn_mbcnt_hi(~0u, __builtin_amdgcn_mbcnt_lo(~0u, z)); }
__device__ __forceinline__ float shx(float v, int m) {
    const int iv = __float_as_int(v); int r;
    switch (m) {
        case 1:  r = __builtin_amdgcn_ds_swizzle(iv, 0x041F); break;
        case 2:  r = __builtin_amdgcn_ds_swizzle(iv, 0x081F); break;
        case 4:  r = __builtin_amdgcn_ds_swizzle(iv, 0x101F); break;
        case 8:  r = __builtin_amdgcn_ds_swizzle(iv, 0x201F); break;
        case 16: r = __builtin_amdgcn_ds_swizzle(iv, 0x401F); break;
        default: r = __builtin_amdgcn_ds_bpermute((lane_id() ^ 32) << 2, iv); break;
    }
    return __int_as_float(r);
}
__device__ __forceinline__ float rs_of(const __attribute__((address_space(1))) float* SSQ, int row) {
    typedef float f4 __attribute__((ext_vector_type(4)));
    const f4 a = *(const __attribute__((address_space(1))) f4*)(SSQ + (size_t)row * 8), b = *(const __attribute__((address_space(1))) f4*)(SSQ + (size_t)row * 8 + 4);
    return __builtin_amdgcn_rsqf((((a[0] + a[1]) + (a[2] + a[3])) + ((b[0] + b[1]) + (b[2] + b[3]))) * (1.0f / 2048.0f) + 1e-6f);
}
__device__ __forceinline__ void rs8_of(const __attribute__((address_space(1))) float* SSQ, int row0, float (&r)[2][4]) {
    typedef float f4 __attribute__((ext_vector_type(4)));
    f4 a[2][4], b[2][4];
#pragma unroll
    for (int ai = 0; ai < 2; ++ai)
#pragma unroll
        for (int m = 0; m < 4; ++m) { const __attribute__((address_space(1))) f4* p = (const __attribute__((address_space(1))) f4*)(SSQ + (size_t)(row0 + ai * 128 + m * 16) * 8); a[ai][m] = p[0]; b[ai][m] = p[1]; }
#pragma unroll
    for (int ai = 0; ai < 2; ++ai)
#pragma unroll
        for (int m = 0; m < 4; ++m) { r[ai][m] = __builtin_amdgcn_rsqf((((a[ai][m][0] + a[ai][m][1]) + (a[ai][m][2] + a[ai][m][3])) + ((b[ai][m][0] + b[ai][m][1]) + (b[ai][m][2] + b[ai][m][3]))) * (1.0f / 2048.0f) + 1e-6f);
            asm volatile("" : "+v"(r[ai][m])); }
}
struct GUnit { const PG8_GAS char* a; const PG8_GAS char* b; int sd; int orow, ocol, kind, nt, srow; };

__device__ __forceinline__ void tile_of(int wgid, int nM, int nN, int& pm, int& pn) {
    const int nwg = nM * nN;
    { const int q = nwg / NXCD, r = nwg % NXCD, xcd = wgid % NXCD, off = wgid / NXCD; wgid = (xcd < r ? xcd * (q + 1) : r * (q + 1) + (xcd - r) * q) + off; }
    const int nig = WGM * nN, gid = wgid / nig, fm = gid * WGM, gsz = (nM - fm) < WGM ? (nM - fm) : WGM;
    pm = fm + ((wgid % nig) % gsz); pn = (wgid % nig) / gsz;
}

__device__ __forceinline__ unsigned cvt_pk_bf16(float lo, float hi) { unsigned r; asm volatile("v_cvt_pk_bf16_f32 %0, %1, %2" : "=v"(r) : "v"(lo), "v"(hi)); return r; }
__device__ __forceinline__ float fast_sigmoid(float x) { return __builtin_amdgcn_rcpf(1.0f + __builtin_amdgcn_exp2f(-1.44269504089f * x)); }
__device__ __forceinline__ float silu_f(float x) { return x * fast_sigmoid(x); }
typedef float f32x2 __attribute__((ext_vector_type(2)));
__device__ __forceinline__ unsigned swiglu2_pk(float ga, float gb, float ua, float ub) {
    const f32x2 g = {ga, gb}, u = {ua, ub};
    const f32x2 t = g * -1.44269504089f;
    f32x2 e = {__builtin_amdgcn_exp2f(t.x), __builtin_amdgcn_exp2f(t.y)};
    e = e + 1.0f;
    const f32x2 r = {__builtin_amdgcn_rcpf(e.x), __builtin_amdgcn_rcpf(e.y)};
    const f32x2 h = (g * u) * r;
    return cvt_pk_bf16(h.x, h.y);
}
__device__ __forceinline__ float gelu_f(float x) { const float t = x * (1.0f + 0.044715f * x * x); return x * __builtin_amdgcn_rcpf(1.0f + __builtin_amdgcn_exp2f(-2.30220819814f * t)); }

template <class Epi, class Sched, bool ALIGN_EPI, bool SP2, bool STRIP = false, bool KOUT = true>
__device__ __forceinline__ void gemm_phase(PG8_LAS unsigned char* lds, const int wave_s, const int lda_, const int ldb_, const Sched& S, const Epi& E) {
    int lda = lda_, ldb = ldb_;
    asm volatile("" : "+s"(lda), "+s"(ldb));
    int tid = wave_s * 64 + lane_id(); asm volatile("" : "+v"(tid));
    const int wid = __builtin_amdgcn_readfirstlane(tid >> 6), lane = tid & 63, wr = wid >> 2, wc = wid & 3, fr = lane & 15, fq = lane >> 4;
    unsigned voffA, voffB;
    { int R, C; stage_rc(tid * 16, R, C); const int Rb = Epi::PERM ? ((R & ~31) + perm32(R & 31)) : R;
        voffA = (unsigned)(R * lda + C) * 2u; voffB = (unsigned)(Rb * ldb + C) * 2u; }
    const size_t r64A = (size_t)64 * lda * 2, r64B = (size_t)64 * ldb * 2;
    const size_t kstep = (size_t)(BK * 2);
    const size_t hstepA = (size_t)HALF * lda * 2, hstepB = (size_t)HALF * ldb * 2;
    const unsigned ldsw = (unsigned)wid * 1024u;
    const int aoff = lds_byte(wr * 64 + fr, fq * 8), boff = lds_byte(wc * 32 + fr, fq * 8);
    const bool s_act = STRIP && lane < 16;
    unsigned vs_s = 0; int so_s = 0;
    if constexpr (STRIP) { const int c_ = wid * 16 + (lane & 15), r_ = c_ >> 3, g_ = (c_ & 7) ^ ((r_ >> 1) & 7); vs_s = (unsigned)(r_ * lda) * 2u + (unsigned)(g_ * 16);
        so_s = fr * 128 + ((fq ^ ((fr >> 1) & 7)) * 16); }
    PG8_LAS unsigned char* ldsB = lds + 65536 + boff; asm volatile("" : "+v"(ldsB));
    PG8_LAS unsigned char* ldsS0 = lds + STAGE_BYTES + so_s; PG8_LAS unsigned char* ldsS1 = lds + STAGE_BYTES + (so_s ^ 64);
    unsigned sm0_s = (unsigned)__builtin_amdgcn_readfirstlane((int)(unsigned)(size_t)(lds + STAGE_BYTES + wid * 256));
    if constexpr (STRIP) { asm volatile("" : "+v"(ldsS0), "+v"(ldsS1), "+s"(sm0_s)); }
    static_assert(!STRIP || SP2, "the strip rides on the SP2 loop");
#define PG8_SA(b, h) (((b) * 2 + (h)) * HTB)
#define PG8_SB(b, h) ((4 + (b) * 2 + (h)) * HTB)
#define PG8_STAGE(bufoff, gbase, voff) do { asm volatile("" : "+v"(voff)); const unsigned vo_ = (voff);     \
        _Pragma("unroll") for (int _i = 0; _i < 2; ++_i) { const PG8_GAS char* gb_ = (gbase) + (size_t)_i * r64_##voff; asm volatile("" : "+s"(gb_));     \
        __builtin_amdgcn_global_load_lds((const PG8_GAS unsigned*)(gb_ + vo_), (PG8_LAS unsigned*)(lds + (bufoff) + ldsw + _i * 8192), 16, 0, 0); } } while (0)
#define r64_voffA r64A
#define r64_voffB r64B
#define PG8_LDA(dst, b, h) do { _Pragma("unroll") for (int m = 0; m < 4; ++m) _Pragma("unroll") for (int k = 0; k < 2; ++k) dst[m][k] = *(const PG8_LAS bf16x8*)(lds + PG8_SA(b, h) + aoff + m * 2048 + k * 1024); } while (0)
#define PG8_LDB(dst, b, h) do { _Pragma("unroll") for (int n = 0; n < 2; ++n) _Pragma("unroll") for (int k = 0; k < 2; ++k) dst[n][k] = *(const PG8_LAS bf16x8*)(ldsB + (PG8_SB(b, h) - 65536) + n * 2048 + k * 1024); } while (0)
#define PG8_MMA(ai, bj, At, Bt) do { __builtin_amdgcn_s_setprio(1); \
        if constexpr (KOUT) { _Pragma("unroll") for (int k = 0; k < 2; ++k) _Pragma("unroll") for (int m = 0; m < 4; ++m) _Pragma("unroll") for (int n_ = 0; n_ < 2; ++n_) { const int n = ((m ^ k) & 1) ? 1 - n_ : n_;     \
            acc[ai][bj][m][n] = __builtin_amdgcn_mfma_f32_16x16x32_bf16(Bt[n][k], At[m][k], acc[ai][bj][m][n], 0, 0, 0); } } \
        else { _Pragma("unroll") for (int m = 0; m < 4; ++m) _Pragma("unroll") for (int n = 0; n < 2; ++n) _Pragma("unroll") for (int k = 0; k < 2; ++k) \
            acc[ai][bj][m][n] = __builtin_amdgcn_mfma_f32_16x16x32_bf16(Bt[n][k], At[m][k], acc[ai][bj][m][n], 0, 0, 0); } \
        __builtin_amdgcn_s_setprio(0); } while (0)
#define PG8_SS(b) (STAGE_BYTES + (b) * 2048)
#define PG8_STAGE_S(b, gbase) do { if constexpr (STRIP) { \
        if (s_act) {        \
            const PG8_GAS char* gs_ = (gbase); asm volatile("" : "+v"(vs_s), "+s"(gs_)); const unsigned vs_ = vs_s; \
            __builtin_amdgcn_global_load_lds((const PG8_GAS unsigned*)(gs_ + vs_), (PG8_LAS unsigned*)(size_t)(sm0_s + (b) * 2048), 16, 0, 0); } } } while (0)
#define PG8_LDS_S(b) do { if constexpr (STRIP) { \
        As[0] = *(const PG8_LAS bf16x8*)(ldsS0 + (b) * 2048); As[1] = *(const PG8_LAS bf16x8*)(ldsS1 + (b) * 2048); } } while (0)
#define PG8_MMA_S() do { if constexpr (STRIP) { if (wr) { _Pragma("unroll") for (int k = 0; k < 2; ++k) { acc_s[0] = __builtin_amdgcn_mfma_f32_16x16x32_bf16(B0[1][k], As[k], acc_s[0], 0, 0, 0); acc_s[1] = __builtin_amdgcn_mfma_f32_16x16x32_bf16(B1[1][k], As[k], acc_s[1], 0, 0, 0); } } \
        else { _Pragma("unroll") for (int k = 0; k < 2; ++k) { acc_s[0] = __builtin_amdgcn_mfma_f32_16x16x32_bf16(B0[0][k], As[k], acc_s[0], 0, 0, 0); acc_s[1] = __builtin_amdgcn_mfma_f32_16x16x32_bf16(B1[0][k], As[k], acc_s[1], 0, 0, 0); } } } } while (0)
#define PG8_WAIT_V(n) asm volatile("s_waitcnt vmcnt(" #n ")" ::: "memory")
#define PG8_WAIT_VS(n, ns) do { if constexpr (STRIP) PG8_WAIT_V(ns); else PG8_WAIT_V(n); } while (0)
#define PG8_WAIT_L(n) asm volatile("s_waitcnt lgkmcnt(" #n ")" ::: "memory")
#define PG8_BAR __builtin_amdgcn_s_barrier()
#define PG8_SCHED __builtin_amdgcn_sched_barrier(0)
    GUnit cur, nxt; int ui = 0;
    if (!S.next(0, cur)) return;
    f32x4 acc[2][2][4][2];
#pragma unroll
    for (int a = 0; a < 2; ++a)
#pragma unroll
        for (int b = 0; b < 2; ++b)
#pragma unroll
            for (int m = 0; m < 4; ++m)
#pragma unroll
                for (int n = 0; n < 2; ++n) acc[a][b][m][n] = (f32x4){0.f, 0.f, 0.f, 0.f};
    bf16x8 At[4][2], B0[2][2], B1[2][2];
    bf16x8 As[2]; f32x4 acc_s[2]; acc_s[0] = (f32x4){0.f, 0.f, 0.f, 0.f}; acc_s[1] = (f32x4){0.f, 0.f, 0.f, 0.f};
    const PG8_GAS char* cA = cur.a; const PG8_GAS char* cB = cur.b; int cSd = cur.sd;
    if constexpr (SP2) {
        PG8_STAGE(PG8_SB(0, 0), cB, voffB); PG8_STAGE(PG8_SB(0, 1), cB + hstepB, voffB); PG8_STAGE(PG8_SA(0, 0), cA, voffA); PG8_STAGE_S(0, cA + cSd); PG8_STAGE(PG8_SA(0, 1), cA + hstepA, voffA);
        if (wr == 1) PG8_BAR;
        PG8_WAIT_V(2); PG8_BAR;
        PG8_STAGE(PG8_SB(1, 0), cB + kstep, voffB); PG8_STAGE(PG8_SA(1, 0), cA + kstep, voffA); PG8_STAGE(PG8_SB(1, 1), cB + hstepB + kstep, voffB); PG8_STAGE_S(1, cA + kstep + cSd);
        PG8_WAIT_VS(6, 7); PG8_BAR;
    } else {
        PG8_STAGE(PG8_SB(0, 0), cB, voffB); PG8_STAGE(PG8_SA(0, 0), cA, voffA); PG8_STAGE(PG8_SB(0, 1), cB + hstepB, voffB); PG8_STAGE(PG8_SA(0, 1), cA + hstepA, voffA);
        if (wr == 1) PG8_BAR;
        PG8_WAIT_V(4); PG8_BAR;
        PG8_STAGE(PG8_SB(1, 0), cB + kstep, voffB); PG8_STAGE(PG8_SA(1, 0), cA + kstep, voffA); PG8_STAGE(PG8_SB(1, 1), cB + hstepB + kstep, voffB);
        PG8_WAIT_V(6); PG8_BAR;
    }
    for (;;) {
        const bool has_next = S.next(ui + 1, nxt);
        int nt = cur.nt; asm volatile("" : "+s"(nt));
        const PG8_GAS char* nA = has_next ? nxt.a : cA; const PG8_GAS char* nB = has_next ? nxt.b : cB; const int nSd = has_next ? nxt.sd : cSd;
        for (int t = 0; t < nt; t += 2) {
            const bool last = (t == nt - 2);
            const PG8_GAS char* a1 = cA + (size_t)(t + 1) * kstep;
            const PG8_GAS char* a2 = last ? nA : cA + (size_t)(t + 2) * kstep; const PG8_GAS char* b2 = last ? nB : cB + (size_t)(t + 2) * kstep;
            const PG8_GAS char* a3 = a2 + kstep; const PG8_GAS char* b3 = b2 + kstep;
            const int sd2 = last ? nSd : cSd;
            if constexpr (SP2) {
            PG8_LDB(B0, 0, 0); PG8_LDB(B1, 0, 1); PG8_SCHED; PG8_LDA(At, 0, 0); PG8_LDS_S(0); PG8_STAGE(PG8_SA(1, 1), a1 + hstepA, voffA);
            PG8_WAIT_VS(8, 9); PG8_WAIT_L(0); PG8_BAR; PG8_MMA(0, 0, At, B0); PG8_MMA(0, 1, At, B1); PG8_MMA_S(); PG8_BAR; PG8_SCHED;
            PG8_LDA(At, 0, 1); PG8_STAGE(PG8_SB(0, 0), b2, voffB); PG8_STAGE(PG8_SB(0, 1), b2 + hstepB, voffB); PG8_STAGE(PG8_SA(0, 0), a2, voffA); PG8_STAGE_S(0, a2 + sd2);
            PG8_WAIT_VS(8, 9); PG8_WAIT_L(0); PG8_BAR; PG8_MMA(1, 0, At, B0); PG8_MMA(1, 1, At, B1); PG8_BAR; PG8_SCHED;
            PG8_LDB(B0, 1, 0); PG8_LDB(B1, 1, 1); PG8_SCHED; PG8_LDA(At, 1, 0); PG8_LDS_S(1); PG8_STAGE(PG8_SA(0, 1), a2 + hstepA, voffA);
            PG8_WAIT_VS(8, 9); PG8_WAIT_L(0); PG8_BAR; PG8_MMA(0, 0, At, B0); PG8_MMA(0, 1, At, B1); PG8_MMA_S(); PG8_BAR; PG8_SCHED;
            PG8_LDA(At, 1, 1); PG8_STAGE(PG8_SB(1, 0), b3, voffB); PG8_STAGE(PG8_SB(1, 1), b3 + hstepB, voffB); PG8_STAGE(PG8_SA(1, 0), a3, voffA); PG8_STAGE_S(1, a3 + sd2);
            PG8_WAIT_VS(8, 9); PG8_WAIT_L(0); PG8_BAR; PG8_MMA(1, 0, At, B0); PG8_MMA(1, 1, At, B1); PG8_BAR; PG8_SCHED;
            } else {
            PG8_LDB(B0, 0, 0); PG8_SCHED; PG8_LDA(At, 0, 0); PG8_STAGE(PG8_SA(1, 1), a1 + hstepA, voffA);
            PG8_WAIT_L(8); PG8_BAR; PG8_WAIT_L(0); PG8_MMA(0, 0, At, B0); PG8_BAR; PG8_SCHED;
            PG8_LDB(B1, 0, 1); PG8_STAGE(PG8_SB(0, 0), b2, voffB);
            PG8_BAR; PG8_WAIT_L(0); PG8_MMA(0, 1, At, B1); PG8_BAR;
            PG8_LDA(At, 0, 1); PG8_STAGE(PG8_SA(0, 0), a2, voffA);
            PG8_BAR; PG8_WAIT_L(0); PG8_MMA(1, 0, At, B0); PG8_BAR; PG8_SCHED;
            PG8_STAGE(PG8_SB(0, 1), b2 + hstepB, voffB);
            PG8_WAIT_V(6); PG8_BAR; PG8_MMA(1, 1, At, B1); PG8_BAR;
            PG8_LDB(B0, 1, 0); PG8_SCHED; PG8_LDA(At, 1, 0); PG8_STAGE(PG8_SA(0, 1), a2 + hstepA, voffA);
            PG8_WAIT_L(8); PG8_BAR; PG8_WAIT_L(0); PG8_MMA(0, 0, At, B0); PG8_BAR; PG8_SCHED;
            PG8_LDB(B1, 1, 1); PG8_STAGE(PG8_SB(1, 0), b3, voffB);
            PG8_BAR; PG8_WAIT_L(0); PG8_MMA(0, 1, At, B1); PG8_BAR;
            PG8_LDA(At, 1, 1); PG8_STAGE(PG8_SA(1, 0), a3, voffA);
            PG8_BAR; PG8_WAIT_L(0); PG8_MMA(1, 0, At, B0); PG8_BAR; PG8_SCHED;
            PG8_STAGE(PG8_SB(1, 1), b3 + hstepB, voffB);
            PG8_WAIT_V(6); PG8_BAR; PG8_MMA(1, 1, At, B1); PG8_BAR;
            }
        }
        if constexpr (ALIGN_EPI) { if (wr == 0) PG8_BAR; }
        if constexpr (!Epi::AFTER_DRAIN) { const int le_ = lane_id(), fre_ = le_ & 15, fqe_ = le_ >> 4;
            E(acc, cur, wr, wc, fre_, fqe_); if constexpr (STRIP) { E.strip(acc_s, cur, wr, wc, fre_, fqe_); acc_s[0] = (f32x4){0.f, 0.f, 0.f, 0.f}; acc_s[1] = (f32x4){0.f, 0.f, 0.f, 0.f}; } }
        if (!has_next) break;
#pragma unroll
        for (int a = 0; a < 2; ++a)
#pragma unroll
            for (int b = 0; b < 2; ++b)
#pragma unroll
                for (int m = 0; m < 4; ++m)
#pragma unroll
                    for (int n = 0; n < 2; ++n) acc[a][b][m][n] = (f32x4){0.f, 0.f, 0.f, 0.f};
        cur = nxt; cA = nA; cB = nB; cSd = nSd; ++ui;
        if constexpr (ALIGN_EPI) { if (wr == 1) PG8_BAR; }
    }
    PG8_WAIT_V(0);
    if constexpr (!ALIGN_EPI) { if (wr == 0) PG8_BAR; }
    PG8_BAR;
    if constexpr (Epi::AFTER_DRAIN) {
        int t2 = wave_s * 64 + lane_id(); asm volatile("" : "+v"(t2));
        const int wid2 = __builtin_amdgcn_readfirstlane(t2 >> 6), lane2 = t2 & 63;
        if constexpr (STRIP) E.fused(acc, acc_s, cur, wid2 >> 2, wid2 & 3, lane2 & 15, lane2 >> 4, lds, wid2, lane2); else E.fused(acc, cur, wid2 >> 2, wid2 & 3, lane2 & 15, lane2 >> 4, lds, wid2, lane2); }
#undef PG8_SA
#undef PG8_SB
#undef PG8_STAGE
#undef r64_voffA
#undef r64_voffB
#undef PG8_LDA
#undef PG8_LDB
#undef PG8_MMA
#undef PG8_WAIT_V
#undef PG8_WAIT_VS
#undef PG8_SS
#undef PG8_STAGE_S
#undef PG8_LDS_S
#undef PG8_MMA_S
#undef PG8_WAIT_L
#undef PG8_BAR
#undef PG8_SCHED
}

typedef f32x4 acc_t[2][2][4][2];

struct EpiD {
    static constexpr bool PERM = true, AFTER_DRAIN = false;
    PG8_GAS bf16_t* D; PG8_GAS float* SL;
    __device__ __forceinline__ void strip(const f32x4 (&as)[2], const GUnit& u, int wr, int wc, int fr, int fq) const {
        PG8_GAS bf16_t* rowp = D + (size_t)(u.srow + fr) * 2048 + u.ocol + wc * 32 + 8 * fq + 4 * wr;
#pragma unroll
        for (int bj = 0; bj < 2; ++bj) { u32x2 w; w.x = cvt_pk_bf16(as[bj][0], as[bj][1]); w.y = cvt_pk_bf16(as[bj][2], as[bj][3]); *(PG8_GAS u32x2*)(rowp + bj * HALF) = w; }
    }
    __device__ __forceinline__ void operator()(const acc_t& acc, const GUnit& u, int wr, int wc, int fr, int fq) const {
        const int row0 = u.orow + wr * 64 + fr, col0 = u.ocol + wc * 32 + 8 * fq;
        if (u.kind == KIND_SLAB) {
#pragma unroll
            for (int ai = 0; ai < 2; ++ai)
#pragma unroll
                for (int m = 0; m < 4; ++m) { PG8_GAS float* rowp = SL + (size_t)(row0 + ai * HALF + m * 16) * 2048 + col0;
#pragma unroll
                    for (int bj = 0; bj < 2; ++bj) { *(PG8_GAS f32x4*)(rowp + bj * HALF) = acc[ai][bj][m][0]; *(PG8_GAS f32x4*)(rowp + bj * HALF + 4) = acc[ai][bj][m][1]; } }
        } else {
#pragma unroll
            for (int ai = 0; ai < 2; ++ai)
#pragma unroll
                for (int m = 0; m < 4; ++m) { PG8_GAS bf16_t* rowp = D + (size_t)(row0 + ai * HALF + m * 16) * 2048 + col0;
#pragma unroll
                    for (int bj = 0; bj < 2; ++bj) { const f32x4 v0 = acc[ai][bj][m][0], v1 = acc[ai][bj][m][1];
                        u32x4 w; w.x = cvt_pk_bf16(v0[0], v0[1]); w.y = cvt_pk_bf16(v0[2], v0[3]); w.z = cvt_pk_bf16(v1[0], v1[1]); w.w = cvt_pk_bf16(v1[2], v1[3]);
                        *(PG8_GAS u32x4*)(rowp + bj * HALF) = w; } }
        }
    }
};
struct EpiFfnIn {
    static constexpr bool PERM = true, AFTER_DRAIN = false;
    PG8_GAS bf16_t* O; int ldo; PG8_GAS float* KF; PG8_GAS bf16_t* KB; PG8_GAS float* VF; PG8_GAS bf16_t* VT; const PG8_GAS float* RS;
    __device__ __forceinline__ void operator()(const acc_t& acc, const GUnit& u, int wr, int wc, int fr, int fq) const {
        const int row0 = u.orow + wr * 64 + fr, col0 = u.ocol + wc * 32 + 8 * fq;
        if (u.kind == 0) {
            float rsv[2][4]; rs8_of(RS, row0, rsv);
#pragma unroll
            for (int ai = 0; ai < 2; ++ai)
#pragma unroll
                for (int m = 0; m < 4; ++m) { PG8_GAS bf16_t* rowp = O + (size_t)(row0 + ai * HALF + m * 16) * ldo + col0; const float rs = rsv[ai][m];
                    const f32x4 g0 = acc[ai][0][m][0] * rs, g1 = acc[ai][0][m][1] * rs, u0 = acc[ai][1][m][0] * rs, u1 = acc[ai][1][m][1] * rs;
                    u32x4 w; w.x = swiglu2_pk(g0[0], g0[1], u0[0], u0[1]); w.y = swiglu2_pk(g0[2], g0[3], u0[2], u0[3]);
                    w.z = swiglu2_pk(g1[0], g1[1], u1[0], u1[1]); w.w = swiglu2_pk(g1[2], g1[3], u1[2], u1[3]);
                    *(PG8_GAS u32x4*)rowp = w; }
        } else if (u.kind == 1) {
#pragma unroll
            for (int ai = 0; ai < 2; ++ai)
#pragma unroll
                for (int m = 0; m < 4; ++m) { const size_t ro = (size_t)(row0 + ai * HALF + m * 16) * 2048 + col0;
#pragma unroll
                    for (int bj = 0; bj < 2; ++bj) { const f32x4 v0 = acc[ai][bj][m][0], v1 = acc[ai][bj][m][1];
                        *(PG8_GAS f32x4*)(KF + ro + bj * HALF) = v0; *(PG8_GAS f32x4*)(KF + ro + bj * HALF + 4) = v1;
                        u32x4 w; w.x = cvt_pk_bf16(v0[0], v0[1]); w.y = cvt_pk_bf16(v0[2], v0[3]); w.z = cvt_pk_bf16(v1[0], v1[1]); w.w = cvt_pk_bf16(v1[2], v1[3]);
                        *(PG8_GAS u32x4*)(KB + ro + bj * HALF) = w; } }
        } else {
#pragma unroll
            for (int ai = 0; ai < 2; ++ai)
#pragma unroll
                for (int m = 0; m < 4; ++m) { const int row = row0 + ai * HALF + m * 16;
#pragma unroll
                    for (int bj = 0; bj < 2; ++bj) { const f32x4 v0 = acc[ai][bj][m][0], v1 = acc[ai][bj][m][1];
                        u32x4 w; w.x = cvt_pk_bf16(v0[0], v0[1]); w.y = cvt_pk_bf16(v0[2], v0[3]); w.z = cvt_pk_bf16(v1[0], v1[1]); w.w = cvt_pk_bf16(v1[2], v1[3]);
                        *(PG8_GAS u32x4*)(VT + (size_t)row * 1024 + col0 + bj * HALF) = w;
                        PG8_GAS float* vp = VF + (size_t)(col0 + bj * HALF) * 2048 + row;
#pragma unroll
                        for (int j = 0; j < 4; ++j) { vp[(size_t)j * 2048] = v0[j]; vp[(size_t)(4 + j) * 2048] = v1[j]; } } }
        }
    }
};
struct EpiMixIn {
    static constexpr bool PERM = true, AFTER_DRAIN = false;
    PG8_GAS float* XL; PG8_GAS bf16_t* GL; PG8_GAS bf16_t* UG; PG8_GAS float* VG; PG8_GAS float* VST; PG8_GAS float* SL;
    const PG8_GAS float* RS;
    __device__ __forceinline__ void strip(const f32x4 (&as)[2], const GUnit& u, int wr, int wc, int fr, int fq) const {
        const int row = u.srow + fr, col = u.ocol + wc * 32 + 8 * fq + 4 * wr; const float rs = rs_of(RS, row);
#pragma unroll
        for (int bj = 0; bj < 2; ++bj) { const f32x4 v = as[bj] * rs;
            if (u.kind == 0) *(PG8_GAS f32x4*)(XL + (size_t)row * 1024 + col + bj * HALF) = v;
            else if (u.kind == 3) *(PG8_GAS f32x4*)(VG + (size_t)row * 1024 + col + bj * HALF) = (f32x4){gelu_f(v[0]), gelu_f(v[1]), gelu_f(v[2]), gelu_f(v[3])};
            else { u32x2 w; w.x = cvt_pk_bf16(gelu_f(v[0]), gelu_f(v[1])); w.y = cvt_pk_bf16(gelu_f(v[2]), gelu_f(v[3])); *(PG8_GAS u32x2*)(((u.kind == 1) ? GL : UG) + (size_t)row * 1024 + col + bj * HALF) = w; } }
    }
    __device__ __forceinline__ void operator()(const acc_t& acc, const GUnit& u, int wr, int wc, int fr, int fq) const {
        const int row0 = u.orow + wr * 64 + fr, col0 = u.ocol + wc * 32 + 8 * fq;
        float rsv[2][4]; rs8_of(RS, row0, rsv);
        if (u.kind == 0 || u.kind == KIND_SLAB) {
            PG8_GAS float* Fb = (u.kind == 0) ? XL : SL; const int ldf = (u.kind == 0) ? 1024 : 4096;
#pragma unroll
            for (int ai = 0; ai < 2; ++ai)
#pragma unroll
                for (int m = 0; m < 4; ++m) { PG8_GAS float* rowp = Fb + (size_t)(row0 + ai * HALF + m * 16) * ldf + col0; const float rs = rsv[ai][m];
#pragma unroll
                    for (int bj = 0; bj < 2; ++bj) { *(PG8_GAS f32x4*)(rowp + bj * HALF) = acc[ai][bj][m][0] * rs; *(PG8_GAS f32x4*)(rowp + bj * HALF + 4) = acc[ai][bj][m][1] * rs; } }
        } else if (u.kind == 3) {
#pragma unroll
            for (int ai = 0; ai < 2; ++ai)
#pragma unroll
                for (int m = 0; m < 4; ++m) { const int row = row0 + ai * HALF + m * 16; PG8_GAS float* rowp = VG + (size_t)row * 1024 + col0; float s = 0.f, q = 0.f; const float rs = rsv[ai][m];
#pragma unroll
                    for (int bj = 0; bj < 2; ++bj) { f32x4 v0 = acc[ai][bj][m][0] * rs, v1 = acc[ai][bj][m][1] * rs;
#pragma unroll
                        for (int j = 0; j < 4; ++j) { v0[j] = gelu_f(v0[j]); v1[j] = gelu_f(v1[j]); s += v0[j] + v1[j]; q += v0[j] * v0[j] + v1[j] * v1[j]; }
                        *(PG8_GAS f32x4*)(rowp + bj * HALF) = v0; *(PG8_GAS f32x4*)(rowp + bj * HALF + 4) = v1; }
                    s += pg8::shx(s, 16); s += pg8::shx(s, 32); q += pg8::shx(q, 16); q += pg8::shx(q, 32);
                    if (fq == 0) *(PG8_GAS f32x2*)(VST + ((size_t)row * 16 + (u.ocol >> 8) * 4 + wc) * 2) = (f32x2){s, q}; }
        } else {
            PG8_GAS bf16_t* O = (u.kind == 1) ? GL : UG;
#pragma unroll
            for (int ai = 0; ai < 2; ++ai)
#pragma unroll
                for (int m = 0; m < 4; ++m) { PG8_GAS bf16_t* rowp = O + (size_t)(row0 + ai * HALF + m * 16) * 1024 + col0; const float rs = rsv[ai][m];
#pragma unroll
                    for (int bj = 0; bj < 2; ++bj) { const f32x4 v0 = acc[ai][bj][m][0] * rs, v1 = acc[ai][bj][m][1] * rs;
                        u32x4 w; w.x = cvt_pk_bf16(gelu_f(v0[0]), gelu_f(v0[1])); w.y = cvt_pk_bf16(gelu_f(v0[2]), gelu_f(v0[3])); w.z = cvt_pk_bf16(gelu_f(v1[0]), gelu_f(v1[1])); w.w = cvt_pk_bf16(gelu_f(v1[2]), gelu_f(v1[3]));
                        *(PG8_GAS u32x4*)(rowp + bj * HALF) = w; } }
        }
    }
};
struct EpiQ {
    static constexpr bool PERM = true, AFTER_DRAIN = false;
    PG8_GAS bf16_t* Q; PG8_GAS float* SL; const PG8_GAS float* RS; int mp;
    __device__ __forceinline__ void strip(const f32x4 (&as)[2], const GUnit& u, int wr, int wc, int fr, int fq) const {
        const int row = u.srow + fr; const float rs = rs_of(RS, row); PG8_GAS bf16_t* rowp = Q + (size_t)row * 2048 + u.ocol + wc * 32 + 8 * fq + 4 * wr;
#pragma unroll
        for (int bj = 0; bj < 2; ++bj) { u32x2 w; w.x = cvt_pk_bf16(as[bj][0] * rs, as[bj][1] * rs); w.y = cvt_pk_bf16(as[bj][2] * rs, as[bj][3] * rs); *(PG8_GAS u32x2*)(rowp + bj * HALF) = w; }
    }
    __device__ __forceinline__ void operator()(const acc_t& acc, const GUnit& u, int wr, int wc, int fr, int fq) const {
        const int row0 = u.orow + wr * 64 + fr, col0 = u.ocol + wc * 32 + 8 * fq;
        const int rsrow0 = (u.kind == KIND_SLAB) ? mp + ((u.orow & 511) + wr * 64 + fr) : row0;
        float rsv[2][4]; rs8_of(RS, rsrow0, rsv);
        if (u.kind == KIND_SLAB) {
#pragma unroll
            for (int ai = 0; ai < 2; ++ai)
#pragma unroll
                for (int m = 0; m < 4; ++m) { PG8_GAS float* rowp = SL + (size_t)(row0 + ai * HALF + m * 16) * 2048 + col0; const float rs = rsv[ai][m];
#pragma unroll
                    for (int bj = 0; bj < 2; ++bj) { *(PG8_GAS f32x4*)(rowp + bj * HALF) = acc[ai][bj][m][0] * rs; *(PG8_GAS f32x4*)(rowp + bj * HALF + 4) = acc[ai][bj][m][1] * rs; } }
        } else {
#pragma unroll
            for (int ai = 0; ai < 2; ++ai)
#pragma unroll
                for (int m = 0; m < 4; ++m) { PG8_GAS bf16_t* rowp = Q + (size_t)(row0 + ai * HALF + m * 16) * 2048 + col0; const float rs = rsv[ai][m];
#pragma unroll
                    for (int bj = 0; bj < 2; ++bj) { const f32x4 v0 = acc[ai][bj][m][0] * rs, v1 = acc[ai][bj][m][1] * rs;
                        u32x4 w; w.x = cvt_pk_bf16(v0[0], v0[1]); w.y = cvt_pk_bf16(v0[2], v0[3]); w.z = cvt_pk_bf16(v1[0], v1[1]); w.w = cvt_pk_bf16(v1[2], v1[3]);
                        *(PG8_GAS u32x4*)(rowp + bj * HALF) = w; } }
        }
    }
};
struct EpiBf16 {
    static constexpr bool PERM = true, AFTER_DRAIN = false;
    PG8_GAS bf16_t* O; int ldo;
    __device__ __forceinline__ void operator()(const acc_t& acc, const GUnit& u, int wr, int wc, int fr, int fq) const {
        const int row0 = u.orow + wr * 64 + fr, col0 = u.ocol + wc * 32 + 8 * fq;
#pragma unroll
        for (int ai = 0; ai < 2; ++ai)
#pragma unroll
            for (int m = 0; m < 4; ++m) { PG8_GAS bf16_t* rowp = O + (size_t)(row0 + ai * HALF + m * 16) * ldo + col0;
#pragma unroll
                for (int bj = 0; bj < 2; ++bj) { const f32x4 v0 = acc[ai][bj][m][0], v1 = acc[ai][bj][m][1];
                    u32x4 w; w.x = cvt_pk_bf16(v0[0], v0[1]); w.y = cvt_pk_bf16(v0[2], v0[3]); w.z = cvt_pk_bf16(v1[0], v1[1]); w.w = cvt_pk_bf16(v1[2], v1[3]);
                    *(PG8_GAS u32x4*)(rowp + bj * HALF) = w; } }
    }
};
struct EpiSoftmax {
    static constexpr bool PERM = true, AFTER_DRAIN = true;
    PG8_GAS bf16_t* P; int ldp; float scale_log2e;
    __device__ __forceinline__ void fused(acc_t& acc, const GUnit& u, int wr, int wc, int fr, int fq, PG8_LAS unsigned char* lds, int wid, int lane) const {
        PG8_LAS float* RM = (PG8_LAS float*)lds;
        PG8_LAS float* RS = (PG8_LAS float*)(lds + 4096);
#pragma unroll
        for (int ai = 0; ai < 2; ++ai)
#pragma unroll
            for (int m = 0; m < 4; ++m) { float mx = -3.0e38f;
#pragma unroll
                for (int bj = 0; bj < 2; ++bj)
#pragma unroll
                    for (int n = 0; n < 2; ++n) { const f32x4 x = acc[ai][bj][m][n]; mx = fmaxf(mx, fmaxf(fmaxf(x[0], x[1]), fmaxf(x[2], x[3]))); }
                mx = fmaxf(mx, pg8::shx(mx, 16)); mx = fmaxf(mx, pg8::shx(mx, 32));
                if (fq == 0) RM[(ai * HALF + wr * 64 + m * 16 + fr) * 4 + wc] = mx; }
        asm volatile("s_waitcnt lgkmcnt(0)" ::: "memory"); __builtin_amdgcn_s_barrier(); asm volatile("" ::: "memory");
#pragma unroll
        for (int ai = 0; ai < 2; ++ai)
#pragma unroll
            for (int m = 0; m < 4; ++m) { const int r = ai * HALF + wr * 64 + m * 16 + fr; const f32x4 mm = *(const PG8_LAS f32x4*)(RM + r * 4);
                const float mx = fmaxf(fmaxf(mm[0], mm[1]), fmaxf(mm[2], mm[3])) * scale_log2e; float s = 0.f;
#pragma unroll
                for (int bj = 0; bj < 2; ++bj)
#pragma unroll
                    for (int n = 0; n < 2; ++n) { f32x4 x = acc[ai][bj][m][n];
#pragma unroll
                        for (int j = 0; j < 4; ++j) { x[j] = __builtin_amdgcn_exp2f(x[j] * scale_log2e - mx); s += x[j]; }
                        acc[ai][bj][m][n] = x; }
                s += pg8::shx(s, 16); s += pg8::shx(s, 32);
                if (fq == 0) RS[r * 4 + wc] = s; }
        asm volatile("s_waitcnt lgkmcnt(0)" ::: "memory"); __builtin_amdgcn_s_barrier(); asm volatile("" ::: "memory");
        const int row0 = u.orow + wr * 64 + fr, col0 = u.ocol + wc * 32 + 8 * fq;
#pragma unroll
        for (int ai = 0; ai < 2; ++ai)
#pragma unroll
            for (int m = 0; m < 4; ++m) { const int r = ai * HALF + wr * 64 + m * 16 + fr; const f32x4 ss = *(const PG8_LAS f32x4*)(RS + r * 4);
                const float inv = 1.0f / ((ss[0] + ss[1]) + (ss[2] + ss[3])); PG8_GAS bf16_t* rowp = P + (size_t)(row0 + ai * HALF + m * 16) * ldp + col0;
#pragma unroll
                for (int bj = 0; bj < 2; ++bj) { const f32x4 v0 = acc[ai][bj][m][0] * inv, v1 = acc[ai][bj][m][1] * inv;
                    u32x4 w; w.x = cvt_pk_bf16(v0[0], v0[1]); w.y = cvt_pk_bf16(v0[2], v0[3]); w.z = cvt_pk_bf16(v1[0], v1[1]); w.w = cvt_pk_bf16(v1[2], v1[3]);
                    *(PG8_GAS u32x4*)(rowp + bj * HALF) = w; } }
        asm volatile("s_waitcnt lgkmcnt(0)" ::: "memory"); __builtin_amdgcn_s_barrier(); asm volatile("" ::: "memory");
    }
};
struct EpiT {
    static constexpr bool PERM = true, AFTER_DRAIN = true;
    const PG8_GAS float* XF0; const PG8_GAS float* XF1;
    PG8_GAS bf16_t* XH; PG8_GAS float* OUT; const PG8_GAS float* G1; float c;
    PG8_GAS float* XB; PG8_GAS unsigned* CNT; PG8_GAS float* SSQ; int mode;
    __device__ __forceinline__ void fused(acc_t& acc, f32x4 (&as)[2], const GUnit& u, int wr, int wc, int fr, int fq, PG8_LAS unsigned char* lds, int wid, int lane) const {
        PG8_LAS float* PW = (PG8_LAS float*)(lds + STAGE_BYTES);
        PG8_LAS float* PS = (PG8_LAS float*)(lds + STAGE_BYTES + 4096);
        PG8_LAS float* SR = (PG8_LAS float*)(lds + STAGE_BYTES + 4608);
        const int pm = u.orow >> 8, pn = u.ocol >> 8, tid = wid * 64 + lane;
        unsigned ldsx_ = (unsigned)(size_t)(lds + wid * 1024); asm volatile("" : "+s"(ldsx_));
        PG8_LAS unsigned char* ldsx = (PG8_LAS unsigned char*)(size_t)ldsx_;
        if (mode != 1) {
#pragma unroll
            for (int ai = 0; ai < 2; ++ai)
#pragma unroll
                for (int m = 0; m < 4; ++m)
#pragma unroll
                    for (int bj = 0; bj < 2; ++bj)
                        __builtin_amdgcn_global_load_lds((const PG8_GAS unsigned*)(XH + (size_t)(u.orow + ai * HALF + wr * 64 + m * 16 + fr) * 2048 + u.ocol + bj * HALF + wc * 32 + 8 * fq),
                                                         (PG8_LAS unsigned*)(ldsx + ((ai * 4 + m) * 2 + bj) * 8192), 16, 0, 0);
        }
#pragma unroll
        for (int ai = 0; ai < 2; ++ai)
#pragma unroll
            for (int m = 0; m < 4; ++m) { float q = 0.f;
#pragma unroll
                for (int bj = 0; bj < 2; ++bj)
#pragma unroll
                    for (int n = 0; n < 2; ++n) { const f32x4 v = acc[ai][bj][m][n]; q += (v[0] * v[0] + v[1] * v[1]) + (v[2] * v[2] + v[3] * v[3]); }
                q += pg8::shx(q, 16); q += pg8::shx(q, 32);
                if (fq == 0) PW[(ai * HALF + wr * 64 + m * 16 + fr) * 4 + wc] = q; }
        { float q = 0.f;
#pragma unroll
            for (int bj = 0; bj < 2; ++bj) { const f32x4 v = as[bj]; q += (v[0] * v[0] + v[1] * v[1]) + (v[2] * v[2] + v[3] * v[3]); }
            q += pg8::shx(q, 16); q += pg8::shx(q, 32);
            if (fq == 0) PS[fr * 8 + wid] = q; }
        asm volatile("s_waitcnt lgkmcnt(0)" ::: "memory"); __builtin_amdgcn_s_barrier(); asm volatile("" ::: "memory");
        PG8_GAS float* xb = XB + ((size_t)pm * 272) * 8;
        if (tid < 272) { float p;
            if (tid < 256) { const f32x4 t = *(const PG8_LAS f32x4*)(PW + tid * 4); p = (t[0] + t[1]) + (t[2] + t[3]); }
            else { const f32x4 t0 = *(const PG8_LAS f32x4*)(PS + (tid - 256) * 8), t1 = *(const PG8_LAS f32x4*)(PS + (tid - 256) * 8 + 4); p = ((t0[0] + t0[1]) + (t0[2] + t0[3])) + ((t1[0] + t1[1]) + (t1[2] + t1[3])); }
            __hip_atomic_store((PG8_GAS unsigned*)(xb + (size_t)tid * 8 + pn), __float_as_uint(p), __ATOMIC_RELAXED, __HIP_MEMORY_SCOPE_AGENT); }
        asm volatile("s_waitcnt vmcnt(0)" ::: "memory"); __builtin_amdgcn_s_barrier(); asm volatile("" ::: "memory");
        if (tid == 0) (void)__hip_atomic_fetch_add(CNT + 16 * pm, 1u, __ATOMIC_RELAXED, __HIP_MEMORY_SCOPE_AGENT);
        if (wid == 0) { unsigned spins = 0;
            while ((unsigned)__builtin_amdgcn_readfirstlane((int)__hip_atomic_load(CNT + 16 * pm, __ATOMIC_RELAXED, __HIP_MEMORY_SCOPE_AGENT)) < 8u) { __builtin_amdgcn_s_sleep(1); if (++spins > (1u << 20)) break; }
            __builtin_amdgcn_fence(__ATOMIC_ACQUIRE, "agent"); asm volatile("s_waitcnt vmcnt(0)" ::: "memory"); }
        __builtin_amdgcn_s_barrier(); asm volatile("" ::: "memory");
        if (tid < 272) { float sum = 0.f;
#pragma unroll
            for (int k = 0; k < 8; ++k) sum += __uint_as_float(__hip_atomic_load((PG8_GAS unsigned*)(xb + (size_t)tid * 8 + k), __ATOMIC_RELAXED, __HIP_MEMORY_SCOPE_AGENT));
            SR[tid] = c * __builtin_amdgcn_rsqf(sum * (1.0f / 2048.0f) + 1e-6f); }
        asm volatile("s_waitcnt lgkmcnt(0)" ::: "memory"); __builtin_amdgcn_s_barrier(); asm volatile("" ::: "memory");
        asm volatile("s_waitcnt vmcnt(0)" ::: "memory");
#pragma unroll
        for (int ai = 0; ai < 2; ++ai)
#pragma unroll
            for (int m = 0; m < 4; ++m) { const int rl = ai * HALF + wr * 64 + m * 16 + fr, grow = u.orow + rl; const float sc = SR[rl]; float q = 0.f;
#pragma unroll
                for (int bj = 0; bj < 2; ++bj) { const int col = u.ocol + bj * HALF + wc * 32 + 8 * fq; const size_t o = (size_t)grow * 2048 + col;
                    f32x4 x0, x1;
                    if (mode == 1) { x0 = *(const PG8_GAS f32x4*)(XF0 + o); x1 = *(const PG8_GAS f32x4*)(XF0 + o + 4); }
                    else { const u32x4 w = *(const PG8_LAS u32x4*)(lds + ((ai * 4 + m) * 2 + bj) * 8192 + wid * 1024 + lane * 16);
                        x0 = (f32x4){__uint_as_float(w.x << 16), __uint_as_float(w.x & 0xffff0000u), __uint_as_float(w.y << 16), __uint_as_float(w.y & 0xffff0000u)};
                        x1 = (f32x4){__uint_as_float(w.z << 16), __uint_as_float(w.z & 0xffff0000u), __uint_as_float(w.w << 16), __uint_as_float(w.w & 0xffff0000u)}; }
                    const f32x4 g0 = *(const PG8_GAS f32x4*)(G1 + col), g1v = *(const PG8_GAS f32x4*)(G1 + col + 4);
                    x0 = x0 + acc[ai][bj][m][0] * sc * g0; x1 = x1 + acc[ai][bj][m][1] * sc * g1v;
                    if (mode == 2) { *(PG8_GAS f32x4*)(OUT + o) = x0; *(PG8_GAS f32x4*)(OUT + o + 4) = x1; }
                    else { u32x4 w; w.x = cvt_pk_bf16(x0[0], x0[1]); w.y = cvt_pk_bf16(x0[2], x0[3]); w.z = cvt_pk_bf16(x1[0], x1[1]); w.w = cvt_pk_bf16(x1[2], x1[3]); *(PG8_GAS u32x4*)(XH + o) = w;
                        q += ((x0[0] * x0[0] + x0[1] * x0[1]) + (x0[2] * x0[2] + x0[3] * x0[3])) + ((x1[0] * x1[0] + x1[1] * x1[1]) + (x1[2] * x1[2] + x1[3] * x1[3])); } }
                q += pg8::shx(q, 16); q += pg8::shx(q, 32);
                if (fq == 0) PW[rl * 4 + wc] = q; }
        { const int grow = u.srow + fr; const float sc = SR[256 + fr]; float q = 0.f;
#pragma unroll
            for (int bj = 0; bj < 2; ++bj) { const int col = u.ocol + bj * HALF + wc * 32 + 8 * fq + 4 * wr; const size_t o = (size_t)grow * 2048 + col;
                f32x4 x0;
                if (mode == 1) x0 = *(const PG8_GAS f32x4*)(XF1 + (size_t)(grow - 8192) * 2048 + col);
                else { const u32x2 w = *(const PG8_GAS u32x2*)(XH + o); x0 = (f32x4){__uint_as_float(w.x << 16), __uint_as_float(w.x & 0xffff0000u), __uint_as_float(w.y << 16), __uint_as_float(w.y & 0xffff0000u)}; }
                const f32x4 g0 = *(const PG8_GAS f32x4*)(G1 + col);
                x0 = x0 + as[bj] * sc * g0;
                if (mode == 2) *(PG8_GAS f32x4*)(OUT + o) = x0;
                else { u32x2 w; w.x = cvt_pk_bf16(x0[0], x0[1]); w.y = cvt_pk_bf16(x0[2], x0[3]); *(PG8_GAS u32x2*)(XH + o) = w; q += (x0[0] * x0[0] + x0[1] * x0[1]) + (x0[2] * x0[2] + x0[3] * x0[3]); } }
            q += pg8::shx(q, 16); q += pg8::shx(q, 32);
            if (fq == 0) PS[fr * 8 + wid] = q; }
        asm volatile("s_waitcnt lgkmcnt(0)" ::: "memory"); __builtin_amdgcn_s_barrier(); asm volatile("" ::: "memory");
        if (mode != 2 && tid < 272) { float p; int grow;
            if (tid < 256) { const f32x4 t = *(const PG8_LAS f32x4*)(PW + tid * 4); p = (t[0] + t[1]) + (t[2] + t[3]); grow = u.orow + tid; }
            else { const f32x4 t0 = *(const PG8_LAS f32x4*)(PS + (tid - 256) * 8), t1 = *(const PG8_LAS f32x4*)(PS + (tid - 256) * 8 + 4); p = ((t0[0] + t0[1]) + (t0[2] + t0[3])) + ((t1[0] + t1[1]) + (t1[2] + t1[3])); grow = u.srow + (tid - 256); }
            SSQ[(size_t)grow * 8 + pn] = p; }
        asm volatile("s_waitcnt lgkmcnt(0)" ::: "memory"); __builtin_amdgcn_s_barrier(); asm volatile("" ::: "memory");
    }
};
}

constexpr int NWAVES = 8;
constexpr int DM = 2048, NB = 4, SEQ = 2048, DEPTH = 2, DECB = 128, DECS = 4;
constexpr int DLRU = 1024, DSGU = 1024, CHUNK = 128, MEML = 256, XAH = 4, XAD = 512, DFF = 5504;
constexpr int MP = NB * SEQ;
constexpr int MS = DECB * DECS;
constexpr int MT = MP + MS;
constexpr int MMEM = NB * MEML;
constexpr float EPS = 1e-6f;

constexpr size_t al256(size_t x) { return (x + 255) & ~(size_t)255; }
constexpr size_t WS_CTL = 0, CTL_ZERO_BYTES = 1u << 20;
constexpr size_t WL_FIN1 = 0;
constexpr size_t WL_FDN1 = WL_FIN1 + (size_t)2 * DFF * DM * 2;
constexpr size_t WL_WIN  = WL_FDN1 + (size_t)DM * DFF * 2;
constexpr size_t WL_WOUT = WL_WIN + (size_t)4096 * DM * 2;
constexpr size_t WL_WQ   = WL_WOUT + (size_t)DM * DM * 2;
constexpr size_t WL_WKV  = WL_WQ + (size_t)DM * DM * 2;
constexpr size_t WL_WO   = WL_WKV + (size_t)4096 * DM * 2;
constexpr size_t WL_FIN2 = WL_WO + (size_t)DM * DM * 2;
constexpr size_t WL_FDN2 = WL_FIN2 + (size_t)2 * DFF * DM * 2;
constexpr size_t WL_LRA  = WL_FDN2 + (size_t)DM * DFF * 2;
constexpr size_t WL_LRI  = WL_LRA + (size_t)8 * 128 * 128 * 2;
constexpr size_t WL_SGW  = WL_LRI + (size_t)8 * 128 * 128 * 2;
constexpr size_t WL_SIZE = al256(WL_SGW + (size_t)8 * 128 * 128 * 2);
constexpr size_t WS_W = CTL_ZERO_BYTES;
constexpr size_t WS_XB   = WS_W + DEPTH * WL_SIZE;
constexpr size_t WS_HB   = WS_XB + (size_t)MT * DM * 4;
constexpr size_t WS_ACT  = WS_HB + (size_t)MT * DM * 2;
constexpr size_t WS_DB   = WS_ACT + (size_t)MT * DFF * 2;
constexpr size_t WS_XL   = WS_DB + (size_t)MT * DM * 4;
constexpr size_t WS_GL   = WS_XL + (size_t)MT * 1024 * 4;
constexpr size_t WS_UG   = WS_GL + (size_t)MT * 1024 * 2;
constexpr size_t WS_VG   = WS_UG + (size_t)MT * 1024 * 2;
constexpr size_t WS_VST  = WS_VG + (size_t)MT * 1024 * 4;
constexpr size_t WS_HLOC = WS_VST + (size_t)MT * 32 * 4;
constexpr size_t WS_PC   = WS_HLOC + (size_t)MP * 1024 * 4;
constexpr size_t WS_CSUM = WS_PC + (size_t)MP * 1024 * 4;
constexpr size_t WS_YMIX = WS_CSUM + (size_t)4 * 16 * 1024 * 2 * 4;
constexpr size_t WS_QB   = WS_YMIX + (size_t)MT * DM * 2;
constexpr size_t WS_PB   = WS_QB + (size_t)MT * DM * 2;
constexpr size_t WS_OB   = WS_PB + (size_t)MP * 1024 * 2;
constexpr size_t WS_MEMN = WS_OB + (size_t)MT * DM * 2;
constexpr size_t WS_KB   = WS_MEMN + (size_t)DEPTH * MMEM * DM * 2;
constexpr size_t WS_VT   = WS_KB + (size_t)MMEM * DM * 2;
constexpr size_t WS_SLAB = WS_VT + (size_t)DM * MMEM * 2;
constexpr int NSPLIT = 8;
constexpr size_t WS_RS   = WS_SLAB + (size_t)NSPLIT * MS * 4096 * 4;
constexpr size_t WS_TXB  = al256(WS_RS + (size_t)MT * 8 * 4);
constexpr size_t WS_CS   = al256(WS_TXB + (size_t)8 * 32 * 272 * 8 * 4);
constexpr size_t WS_END  = WS_CS + (size_t)DEPTH * 512 * 128 * 8;

constexpr size_t OUT_YP = 0, OUT_YS = OUT_YP + (size_t)MP * DM, OUT_MK = OUT_YS + (size_t)MS * DM, OUT_MV = OUT_MK + (size_t)DEPTH * MMEM * DM,
                 OUT_CVP = OUT_MV + (size_t)DEPTH * MMEM * DM, OUT_HP = OUT_CVP + (size_t)DEPTH * NB * 3 * DLRU, OUT_CVS = OUT_HP + (size_t)DEPTH * NB * DLRU,
                 OUT_HS = OUT_CVS + (size_t)DEPTH * DECB * 3 * DLRU, OUT_VS = OUT_HS + (size_t)DEPTH * DECB * DLRU, OUT_END = OUT_VS + (size_t)DEPTH * DECB * DECS * DSGU;

constexpr int CW_BAR = 4096;
constexpr int CW_LRUF = 16384;
constexpr int CW_TC = 49152;
constexpr int CW_XF = 57344;
constexpr int CW_QC = 40960;

constexpr int RING_BYTES = 131072;
constexpr int LDS_BYTES = 155648;
constexpr int MISC_OFF = LDS_BYTES - 256;
constexpr int TAB_OFF = LDS_BYTES - 768;

#define GAS __attribute__((address_space(1)))
#define LAS __attribute__((address_space(3)))
typedef unsigned short bf16;
typedef unsigned v4u __attribute__((ext_vector_type(4)));
typedef unsigned v2u __attribute__((ext_vector_type(2)));
typedef float f32x4 __attribute__((ext_vector_type(4)));
typedef float f32x2 __attribute__((ext_vector_type(2)));
typedef short bf16x8 __attribute__((ext_vector_type(8)));
typedef GAS unsigned gu32;
#define RLX_AGENT __ATOMIC_RELAXED, __HIP_MEMORY_SCOPE_AGENT
#define LDS_WAIT() asm volatile("s_waitcnt lgkmcnt(0)" ::: "memory")
#define VM_WAIT() asm volatile("s_waitcnt vmcnt(0)" ::: "memory")
__device__ __forceinline__ unsigned f2bf(float f) { unsigned u = __builtin_bit_cast(unsigned, f); return (u + 0x7fffu + ((u >> 16) & 1u)) >> 16; }
__device__ __forceinline__ unsigned pk2(float lo, float hi) { return f2bf(lo) | (f2bf(hi) << 16); }
__device__ __forceinline__ float bf2f(unsigned short b) { return __builtin_bit_cast(float, (unsigned)b << 16); }
__device__ __forceinline__ float bflo(unsigned w) { return __builtin_bit_cast(float, w << 16); }
__device__ __forceinline__ float bfhi(unsigned w) { return __builtin_bit_cast(float, w & 0xffff0000u); }

#define XB_TMO      128
#define XB_XCNT(j)  (256  + 64 * (j))
#define XB_XSUB(j)  (1280 + 64 * (j))
#define XB_XGEN(j)  (2304 + 64 * (j))
#define XB_TOP      3328
#define XB_TOPGEN   3392
#define XCD_BAR_WORDS 3456
#define XB_SPIN_CAP (1u << 18)

__device__ __forceinline__ unsigned xb_ld(GAS unsigned* p)              { return __hip_atomic_load(p, __ATOMIC_RELAXED, __HIP_MEMORY_SCOPE_AGENT); }
__device__ __forceinline__ unsigned xb_add(GAS unsigned* p, unsigned v) { return __hip_atomic_fetch_add(p, v, __ATOMIC_RELAXED, __HIP_MEMORY_SCOPE_AGENT); }
__device__ __forceinline__ unsigned xb_xcc_id() { return (unsigned)__builtin_amdgcn_s_getreg((3 << 11) | 20) & 0xFu; }
#define XB_SPIN(cond, bar) do { unsigned _sp = 0; while (cond) { __builtin_amdgcn_s_sleep(1); \
    if ((++_sp & 255u) == 0u) { if (xb_ld(&(bar)[XB_TMO])) break; if (_sp > XB_SPIN_CAP) { xb_add(&(bar)[XB_TMO], 1u); break; } } } } while (0)

struct XcdBarrier {
    GAS unsigned* bar; unsigned x;
    volatile LAS unsigned* st;
};
__device__ __forceinline__ XcdBarrier xcd_barrier_post(GAS unsigned* bar, volatile LAS unsigned* st, bool t0) {
    XcdBarrier b; b.bar = bar; b.x = xb_xcc_id(); b.st = st;
    if (t0) (void)xb_add(&bar[XB_XCNT(b.x)], 1u);
    return b;
}
__device__ __forceinline__ void xcd_barrier_complete(GAS unsigned* bar, unsigned x, unsigned& nloc, unsigned& nx) {
    const unsigned G = gridDim.x * gridDim.y * gridDim.z;
    unsigned sum, cnt, mine, sp = 0u;
    for (;;) {
        sum = 0u; cnt = 0u; mine = 0u;
#pragma unroll
        for (unsigned j = 0; j < 16; ++j) { const unsigned c = xb_ld(&bar[XB_XCNT(j)]); sum += c; cnt += (c > 0u) ? 1u : 0u; mine = (j == x) ? c : mine; }
        if (sum == G) break;
        __builtin_amdgcn_s_sleep(1);
        if ((++sp & 255u) == 0u) { if (xb_ld(&bar[XB_TMO])) break; if (sp > XB_SPIN_CAP) { xb_add(&bar[XB_TMO], 1u); break; } }
    }
    nloc = mine > 0u ? mine : 1u; nx = cnt > 0u ? cnt : 1u;
}
__device__ __forceinline__ void xcd_barrier(const XcdBarrier& b, bool t0) {
    asm volatile("s_waitcnt vmcnt(0)" ::: "memory");
    __syncthreads();
    if (t0) {
        GAS unsigned* bar = b.bar;
        __builtin_amdgcn_s_waitcnt(0);
        unsigned nloc = b.st[0], nx = b.st[1];
        if (nloc == 0u) { xcd_barrier_complete(bar, b.x, nloc, nx); b.st[0] = nloc; b.st[1] = nx; }
        const unsigned old = xb_add(&bar[XB_XSUB(b.x)], 1u);
        const unsigned gen = old / nloc;
        if (old + 1u == (gen + 1u) * nloc) {
            __builtin_amdgcn_fence(__ATOMIC_RELEASE, "agent");
            asm volatile("s_waitcnt vmcnt(0)" ::: "memory");
            const unsigned og = xb_add(&bar[XB_TOP], 1u);
            const unsigned tg = og / nx;
            if (og + 1u == (tg + 1u) * nx) xb_add(&bar[XB_TOPGEN], 1u);
            else XB_SPIN(xb_ld(&bar[XB_TOPGEN]) == tg, bar);
            __builtin_amdgcn_fence(__ATOMIC_ACQUIRE, "agent");
            xb_add(&bar[XB_XGEN(b.x)], 1u);
            asm volatile("s_waitcnt vmcnt(0)" ::: "memory");
        } else {
            XB_SPIN(xb_ld(&bar[XB_XGEN(b.x)]) == gen, bar);
            __builtin_amdgcn_fence(__ATOMIC_ACQUIRE, "agent");
            asm volatile("s_waitcnt vmcnt(0)" ::: "memory");
        }
    }
    __syncthreads();
}

struct Args { const float* in[30]; float* out; unsigned char* ws; int ph_lo, ph_hi; };
typedef const GAS float* cgf; typedef GAS float* gf; typedef const GAS bf16* cgb; typedef GAS bf16* gb; typedef GAS unsigned char* gu8; typedef const GAS char* cgc;

__device__ __forceinline__ unsigned long long tab_ld(LAS unsigned char* lds, int i) {
    const unsigned long long v = *(const LAS unsigned long long*)(lds + TAB_OFF + 8 * i);
    return ((unsigned long long)(unsigned)__builtin_amdgcn_readfirstlane((int)(unsigned)(v >> 32)) << 32) | (unsigned long long)(unsigned)__builtin_amdgcn_readfirstlane((int)(unsigned)v);
}
#define TIN(i) ((cgf)tab_ld(lds, (i)))
#define TOUT() ((gf)tab_ld(lds, 30))
#define TWS() ((gu8)tab_ld(lds, 31))

__device__ __forceinline__ float wave_sum(float v) {
#pragma unroll
    for (int o = 1; o < 64; o <<= 1) v += pg8::shx(v, o);
    return v;
}
__device__ __forceinline__ float wave_max(float v) {
#pragma unroll
    for (int o = 1; o < 64; o <<= 1) v = fmaxf(v, pg8::shx(v, o));
    return v;
}

__device__ __forceinline__ void p0_transpose_item(cgf W, int K, int N, gb WT, int k0, int n0, int orow0, LAS float* scr, int lane, cgf gain = nullptr) {
    if (gain) {
#pragma unroll 8
        for (int i = 0; i < 32; ++i) { const int kk = 2 * i + (lane >> 5); scr[kk * 33 + (lane & 31)] = W[(size_t)(k0 + kk) * N + n0 + (lane & 31)] * gain[k0 + kk]; }
    } else {
#pragma unroll 8
    for (int i = 0; i < 32; ++i) { const int kk = 2 * i + (lane >> 5); scr[kk * 33 + (lane & 31)] = W[(size_t)(k0 + kk) * N + n0 + (lane & 31)]; }
    }
    LDS_WAIT(); asm volatile("" ::: "memory");
    const int c = lane & 7;
#pragma unroll
    for (int j = 0; j < 4; ++j) { const int n = (lane >> 3) + 8 * j; const LAS float* s = scr + (8 * c) * 33 + n;
        v4u o; o.x = pk2(s[0 * 33], s[1 * 33]); o.y = pk2(s[2 * 33], s[3 * 33]); o.z = pk2(s[4 * 33], s[5 * 33]); o.w = pk2(s[6 * 33], s[7 * 33]);
        *(GAS v4u*)(WT + (size_t)(orow0 + n) * K + k0 + 8 * c) = o; }
    LDS_WAIT(); asm volatile("" ::: "memory");
}
__device__ __forceinline__ void p0_mat(cgf W, int K, int N, gb WT, int item, LAS float* scr, int lane, cgf gain = nullptr) {
    const int nblk = N / 32, kb = item / nblk, nb = item % nblk;
    p0_transpose_item(W, K, N, WT, 64 * kb, 32 * nb, 32 * nb, scr, lane, gain);
}
__device__ __forceinline__ void p0_mat_ffn_in(cgf W, gb WT, int item, LAS float* scr, int lane, cgf gain) {
    constexpr int N = 2 * DFF, nblk = N / 32; const int kb = item / nblk, nb = item % nblk; const int n0 = 32 * nb;
    const int j0 = (n0 < DFF) ? n0 : n0 - DFF; const int orow0 = (j0 >> 7) * 256 + (j0 & 127) + ((n0 < DFF) ? 0 : 128);
    p0_transpose_item(W, DM, N, WT, 64 * kb, n0, orow0, scr, lane, gain);
}
__device__ __forceinline__ void rms_row_to_bf16(cgf xrow, cgf g, gb orow, int lane) {
    const GAS f32x4* xr = (const GAS f32x4*)xrow + lane; const GAS f32x4* gr = (const GAS f32x4*)g + lane;
    f32x4 v[8]; float s = 0.f;
#pragma unroll
    for (int j = 0; j < 8; ++j) { v[j] = xr[64 * j]; s += (v[j].x * v[j].x + v[j].y * v[j].y) + (v[j].z * v[j].z + v[j].w * v[j].w); }
    const float rstd = 1.0f / sqrtf(wave_sum(s) * (1.f / DM) + EPS);
    GAS v2u* o8 = (GAS v2u*)orow + lane;
#pragma unroll
    for (int j = 0; j < 8; ++j) { const f32x4 gg = gr[64 * j]; v2u o; o.x = pk2(v[j].x * rstd * gg.x, v[j].y * rstd * gg.y); o.y = pk2(v[j].z * rstd * gg.z, v[j].w * rstd * gg.w); o8[64 * j] = o; }
}
__device__ __forceinline__ void x_row_init(cgf xrow, gb orow, gf rs, int lane) {
    float s = 0.f;
#pragma unroll
    for (int j = 0; j < 4; ++j) { const int col = j * 512 + lane * 8; const f32x4 a = *(const GAS f32x4*)(xrow + col), b = *(const GAS f32x4*)(xrow + col + 4);
        s += (a.x * a.x + a.y * a.y) + (a.z * a.z + a.w * a.w) + (b.x * b.x + b.y * b.y) + (b.z * b.z + b.w * b.w);
        v4u o; o.x = pk2(a.x, a.y); o.y = pk2(a.z, a.w); o.z = pk2(b.x, b.y); o.w = pk2(b.z, b.w); *(GAS v4u*)(orow + col) = o; }
    s = wave_sum(s);
    if (lane == 0) { *(GAS f32x4*)rs = (f32x4){s, 0.f, 0.f, 0.f}; *(GAS f32x4*)(rs + 4) = (f32x4){0.f, 0.f, 0.f, 0.f}; }
}
template <bool FIRST, bool LAST, bool SLABS>
__device__ __forceinline__ void t_row(cgf xf, cgb xh, cgb dh, cgf dsl, cgf g1, float c, gb xo, gf of, gf rs, int lane) {
    float x[32], d[32]; float s = 0.f;
#pragma unroll
    for (int j = 0; j < 4; ++j) { const int col = j * 512 + lane * 8;
        if constexpr (SLABS) { f32x4 a = *(const GAS f32x4*)(dsl + col), b = *(const GAS f32x4*)(dsl + col + 4);
#pragma unroll
            for (int sp = 1; sp < NSPLIT; ++sp) { a = a + *(const GAS f32x4*)(dsl + (size_t)sp * MS * DM + col); b = b + *(const GAS f32x4*)(dsl + (size_t)sp * MS * DM + col + 4); }
            d[8 * j + 0] = a.x; d[8 * j + 1] = a.y; d[8 * j + 2] = a.z; d[8 * j + 3] = a.w; d[8 * j + 4] = b.x; d[8 * j + 5] = b.y; d[8 * j + 6] = b.z; d[8 * j + 7] = b.w;
        } else { const v4u w = *(const GAS v4u*)(dh + col);
            d[8 * j + 0] = bflo(w.x); d[8 * j + 1] = bfhi(w.x); d[8 * j + 2] = bflo(w.y); d[8 * j + 3] = bfhi(w.y); d[8 * j + 4] = bflo(w.z); d[8 * j + 5] = bfhi(w.z); d[8 * j + 6] = bflo(w.w); d[8 * j + 7] = bfhi(w.w); }
        if constexpr (FIRST) { const f32x4 a = *(const GAS f32x4*)(xf + col), b = *(const GAS f32x4*)(xf + col + 4);
            x[8 * j + 0] = a.x; x[8 * j + 1] = a.y; x[8 * j + 2] = a.z; x[8 * j + 3] = a.w; x[8 * j + 4] = b.x; x[8 * j + 5] = b.y; x[8 * j + 6] = b.z; x[8 * j + 7] = b.w;
        } else { const v4u w = *(const GAS v4u*)(xh + col);
            x[8 * j + 0] = bflo(w.x); x[8 * j + 1] = bfhi(w.x); x[8 * j + 2] = bflo(w.y); x[8 * j + 3] = bfhi(w.y); x[8 * j + 4] = bflo(w.z); x[8 * j + 5] = bfhi(w.z); x[8 * j + 6] = bflo(w.w); x[8 * j + 7] = bfhi(w.w); } }
#pragma unroll
    for (int e = 0; e < 32; ++e) s += d[e] * d[e];
    const float rd = c / sqrtf(wave_sum(s) * (1.f / DM) + EPS);
    float s2 = 0.f;
#pragma unroll
    for (int j = 0; j < 4; ++j) { const int col = j * 512 + lane * 8; const f32x4 ga = *(const GAS f32x4*)(g1 + col), gb_ = *(const GAS f32x4*)(g1 + col + 4);
        x[8 * j + 0] += d[8 * j + 0] * rd * ga.x; x[8 * j + 1] += d[8 * j + 1] * rd * ga.y; x[8 * j + 2] += d[8 * j + 2] * rd * ga.z; x[8 * j + 3] += d[8 * j + 3] * rd * ga.w;
        x[8 * j + 4] += d[8 * j + 4] * rd * gb_.x; x[8 * j + 5] += d[8 * j + 5] * rd * gb_.y; x[8 * j + 6] += d[8 * j + 6] * rd * gb_.z; x[8 * j + 7] += d[8 * j + 7] * rd * gb_.w;
        if constexpr (LAST) { *(GAS f32x4*)(of + col) = (f32x4){x[8 * j + 0], x[8 * j + 1], x[8 * j + 2], x[8 * j + 3]}; *(GAS f32x4*)(of + col + 4) = (f32x4){x[8 * j + 4], x[8 * j + 5], x[8 * j + 6], x[8 * j + 7]}; }
        else { v4u o; o.x = pk2(x[8 * j + 0], x[8 * j + 1]); o.y = pk2(x[8 * j + 2], x[8 * j + 3]); o.z = pk2(x[8 * j + 4], x[8 * j + 5]); o.w = pk2(x[8 * j + 6], x[8 * j + 7]); *(GAS v4u*)(xo + col) = o;
#pragma unroll
            for (int e = 0; e < 8; ++e) s2 += x[8 * j + e] * x[8 * j + e]; } }
    if constexpr (!LAST) { s2 = wave_sum(s2); if (lane == 0) *rs = 1.0f / sqrtf(s2 * (1.f / DM) + EPS); }
}

__device__ __forceinline__ void ksplit(int K, int s, int& koff, int& kt) {
    if (K == 2048) { koff = s * 256; kt = 4; }
    else { if (s < 3) { koff = s * 768; kt = 12; } else { koff = 2304 + (s - 3) * 640; kt = 10; } }
}
template <bool MIX>
struct SchedSplit {
    cgc A; cgc B; int lda, ldb, nN, K, G, c;
    __device__ __forceinline__ bool next(int i, pg8::GUnit& u) const {
        int L = i * G + c; const int NP = 32 * nN; int pm, pn;
        if (L < NP) { pg8::tile_of(L, 32, nN, pm, pn);
            u.a = A + (size_t)pm * 256 * lda * 2; u.b = B + (size_t)pn * 256 * ldb * 2; u.orow = pm * 256; u.nt = K / 64;
            if (MIX) { u.ocol = (pn & 3) * 256; u.kind = pn >> 2; } else { u.ocol = pn * 256; u.kind = 0; }
            return true; }
        L -= NP; if (L >= 2 * nN * NSPLIT) return false;
        const int sp = L & (NSPLIT - 1), tile = L >> 3; pm = tile & 1; pn = tile >> 1;
        int koff, kt; ksplit(K, sp, koff, kt);
        u.a = A + ((size_t)(MP + pm * 256) * lda + koff) * 2; u.b = B + ((size_t)pn * 256 * ldb + koff) * 2;
        u.orow = sp * MS + pm * 256; u.ocol = pn * 256; u.kind = pg8::KIND_SLAB; u.nt = kt; return true;
    }
};
struct SchedMixIn {
    cgc A; cgc B; int G, c;
    __device__ __forceinline__ bool next(int i, pg8::GUnit& u) const {
        const int L = i * G + c; if (L >= (MT / 256) * 16) return false;
        int pm, pn; pg8::tile_of(L, MT / 256, 16, pm, pn);
        u.a = A + (size_t)pm * 256 * DM * 2; u.b = B + (size_t)pn * 256 * DM * 2; u.orow = pm * 256; u.ocol = (pn & 3) * 256; u.kind = pn >> 2; u.nt = DM / 64; return true;
    }
};
template <bool MIX>
struct SchedStrip {
    cgc A; cgc B; int lda, ldb, nN, K, G, c;
    __device__ __forceinline__ bool next(int i, pg8::GUnit& u) const {
        const int L = i * G + c; if (L >= 32 * nN) return false;
        int pm, pn; pg8::tile_of(L, 32, nN, pm, pn);
        u.a = A + (size_t)pm * 256 * lda * 2; u.sd = (MP + 16 * pm - 256 * pm) * lda * 2; u.srow = MP + 16 * pm; u.b = B + (size_t)pn * 256 * ldb * 2; u.orow = pm * 256; u.nt = K / 64;
        if (MIX) { u.ocol = (pn & 3) * 256; u.kind = pn >> 2; } else { u.ocol = pn * 256; u.kind = 0; }
        return true;
    }
};
struct SchedFfnIn {
    cgc H; cgc W; cgc MEMN; cgc WKV; int G, c, with_kv;
    static constexpr size_t TS = (size_t)256 * DM * 2;
    __device__ __forceinline__ bool next(int i, pg8::GUnit& u) const {
        int L = i * G + c; int pm, pn; u.nt = DM / 64; u.sd = 0; u.srow = 0;
        constexpr int N0 = (MT / 256) * (2 * DFF / 256), N1 = 32;
        if (L < N0) { pg8::tile_of(L, MT / 256, 2 * DFF / 256, pm, pn); u.a = H + pm * TS; u.b = W + pn * TS; u.orow = pm * 256; u.ocol = pn * 128; u.kind = 0; return true; }
        if (!with_kv) return false;
        L -= N0;
        if (L < N1) { pm = L & 3; pn = L >> 2; u.a = MEMN + pm * TS; u.b = WKV + pn * TS; u.orow = pm * 256; u.ocol = pn * 256; u.kind = 1; return true; }
        L -= N1;
        if (L < N1) { pm = L >> 2; pn = L & 3; u.a = WKV + (8 + pm) * TS; u.b = MEMN + pn * TS; u.orow = pm * 256; u.ocol = pn * 256; u.kind = 2; return true; }
        return false;
    }
};
struct SchedX1 {
    cgc Q; cgc KB; int G, c;
    __device__ __forceinline__ bool next(int i, pg8::GUnit& u) const {
        const int L = i * G + c; if (L >= NB * XAH * 8) return false;
        const int qb = L & 7, h = (L >> 3) & 3, n = L >> 5;
        u.a = Q + ((size_t)(n * SEQ + qb * 256) * DM + h * XAD) * 2; u.b = KB + ((size_t)(n * MEML) * DM + h * XAD) * 2;
        u.orow = n * SEQ + qb * 256; u.ocol = h * 256; u.kind = 0; u.nt = XAD / 64; u.sd = 0; u.srow = 0; return true;
    }
};
struct SchedX2 {
    cgc P; cgc VT; int G, c;
    __device__ __forceinline__ bool next(int i, pg8::GUnit& u) const {
        const int L = i * G + c; if (L >= NB * XAH * 8 * 2) return false;
        const int pn = L & 1, qb = (L >> 1) & 7, h = (L >> 4) & 3, n = L >> 6;
        u.a = P + ((size_t)(n * SEQ + qb * 256) * 1024 + h * 256) * 2; u.b = VT + ((size_t)(h * XAD + pn * 256) * 1024 + n * MEML) * 2;
        u.orow = n * SEQ + qb * 256; u.ocol = h * XAD + pn * 256; u.kind = 0; u.nt = MEML / 64; u.sd = 0; u.srow = 0; return true;
    }
};
struct SchedX2pair {
    cgc P; cgc VT; int cc;
    __device__ __forceinline__ bool next(int i, pg8::GUnit& u) const {
        if (cc < 0 || i >= 2) return false;
        const int pn = i, qb = cc & 7, h = (cc >> 3) & 3, n = cc >> 5;
        u.a = P + ((size_t)(n * SEQ + qb * 256) * 1024 + h * 256) * 2; u.b = VT + ((size_t)(h * XAD + pn * 256) * 1024 + n * MEML) * 2;
        u.orow = n * SEQ + qb * 256; u.ocol = h * XAD + pn * 256; u.kind = 0; u.nt = MEML / 64; u.sd = 0; u.srow = 0; return true;
    }
};

constexpr int LR_XC = 0;
constexpr int LR_A = 67584;
constexpr int LR_W = LR_A + 34816;
constexpr int LR_AA = LR_A;
constexpr int LR_SEG = LR_W + 34816;
constexpr int LR_PAR = LR_SEG + 4096;
static_assert(LR_AA + 67584 <= LR_SEG && LR_PAR + 1536 <= TAB_OFF, "LRU LDS map");

template <bool SAMPLE>
__device__ __forceinline__ void lru_unit(LAS unsigned char* lds, int l, int ui, int tid, int wave, int lane) {
    const int h = ui & 7, ch0 = h * 128;
    const int cidx = SAMPLE ? 0 : ((ui >> 3) & 15), n = SAMPLE ? 0 : (ui >> 7), blk = SAMPLE ? (ui >> 3) : 0;
    const int row0 = SAMPLE ? (MP + blk * 128) : (n * SEQ + cidx * 128);
    LAS float* XC = (LAS float*)(lds + LR_XC); LAS bf16* At = (LAS bf16*)(lds + LR_A); LAS bf16* Wt = (LAS bf16*)(lds + LR_W);
    LAS float* AA = (LAS float*)(lds + LR_AA); LAS float* SEG = (LAS float*)(lds + LR_SEG); LAS float* PAR = (LAS float*)(lds + LR_PAR);
    const int ch = tid & 127, rg = tid >> 7;
    const gu8 ws = TWS(); const gf out = TOUT();
    v4u wa_r[4], wi_r[4];
    { const GAS v4u* sa = (const GAS v4u*)(ws + WS_W + (size_t)l * WL_SIZE + WL_LRA + (size_t)h * 32768); const GAS v4u* si = (const GAS v4u*)(ws + WS_W + (size_t)l * WL_SIZE + WL_LRI + (size_t)h * 32768);
#pragma unroll
      for (int j = 0; j < 4; ++j) { wa_r[j] = sa[tid + 512 * j]; wi_r[j] = si[tid + 512 * j]; } }
    if (tid < 128) { PAR[tid] = TIN(15)[(size_t)l * DLRU + ch0 + tid]; PAR[128 + tid] = TIN(17)[(size_t)l * DLRU + ch0 + tid]; const float lm = TIN(18)[(size_t)l * DLRU + ch0 + tid]; PAR[256 + tid] = -8.0f * log1pf(expf(-lm)); }
    {
        const cgf cw = TIN(12) + (size_t)l * 4 * DLRU + ch0 + ch;
        const float w0 = cw[0], w1 = cw[DLRU], w2 = cw[2 * DLRU], w3 = cw[3 * DLRU], cbv = TIN(13)[(size_t)l * DLRU + ch0 + ch];
        const cgf xp = (cgf)(ws + WS_XL) + (size_t)(row0 + rg * 32) * DLRU + ch0 + ch;
        if constexpr (!SAMPLE) {
            float xm3 = 0.f, xm2 = 0.f, xm1 = 0.f;
            if (cidx > 0 || rg > 0) { xm3 = xp[-3 * DLRU]; xm2 = xp[-2 * DLRU]; xm1 = xp[-1 * DLRU]; }
            float xv[32];
#pragma unroll
            for (int r = 0; r < 32; ++r) xv[r] = xp[(size_t)r * DLRU];
#pragma unroll
            for (int r = 0; r < 32; ++r) { const float x0 = xv[r]; const float xc = cbv + w3 * x0 + w2 * xm1 + w1 * xm2 + w0 * xm3;
                XC[(rg * 32 + r) * 132 + ch] = xc; At[(rg * 32 + r) * 136 + ch] = (bf16)f2bf(xc); xm3 = xm2; xm2 = xm1; xm1 = x0; }
            if (cidx == 15 && rg == 3) { const gf o = out + OUT_CVP + ((size_t)l * NB + n) * 3 * DLRU + ch0 + ch; o[0] = xm3; o[DLRU] = xm2; o[2 * DLRU] = xm1; }
        } else {
#pragma unroll 2
            for (int e = 0; e < 8; ++e) { const int nb = blk * 32 + rg * 8 + e; const cgf sc = TIN(5) + ((size_t)l * DECB + nb) * 3 * DLRU + ch0 + ch;
                float xm3 = sc[0], xm2 = sc[DLRU], xm1 = sc[2 * DLRU];
#pragma unroll
                for (int t = 0; t < 4; ++t) { const int r = e * 4 + t; const float x0 = xp[(size_t)r * DLRU]; const float xc = cbv + w3 * x0 + w2 * xm1 + w1 * xm2 + w0 * xm3;
                    XC[(rg * 32 + r) * 132 + ch] = xc; At[(rg * 32 + r) * 136 + ch] = (bf16)f2bf(xc); xm3 = xm2; xm2 = xm1; xm1 = x0; }
                const gf o = out + OUT_CVS + ((size_t)l * DECB + nb) * 3 * DLRU + ch0 + ch; o[0] = xm3; o[DLRU] = xm2; o[2 * DLRU] = xm1; }
        }
    }
    const int fr = lane & 15, fq = lane >> 4;
    pg8::f32x4 acc_a[8], acc_i[8];
#pragma unroll
    for (int ct = 0; ct < 8; ++ct) { acc_a[ct] = (pg8::f32x4){0.f, 0.f, 0.f, 0.f}; acc_i[ct] = (pg8::f32x4){0.f, 0.f, 0.f, 0.f}; }
    {
#pragma unroll
        for (int j = 0; j < 4; ++j) { const int q = tid + 512 * j; *(LAS v4u*)(Wt + (q >> 4) * 136 + (q & 15) * 8) = wa_r[j]; }
    }
    LDS_WAIT(); __syncthreads();
    bf16x8 af[4];
#pragma unroll
    for (int ks = 0; ks < 4; ++ks) af[ks] = *(const LAS bf16x8*)(At + (wave * 16 + fr) * 136 + ks * 32 + fq * 8);
#pragma unroll
    for (int ct = 0; ct < 8; ++ct)
#pragma unroll
        for (int ks = 0; ks < 4; ++ks) { const bf16x8 bfr = *(const LAS bf16x8*)(Wt + (ct * 16 + fr) * 136 + ks * 32 + fq * 8); acc_a[ct] = __builtin_amdgcn_mfma_f32_16x16x32_bf16(bfr, af[ks], acc_a[ct], 0, 0, 0); }
    LDS_WAIT(); __syncthreads();
    {
#pragma unroll
        for (int j = 0; j < 4; ++j) { const int q = tid + 512 * j; *(LAS v4u*)(Wt + (q >> 4) * 136 + (q & 15) * 8) = wi_r[j]; }
    }
    LDS_WAIT(); __syncthreads();
#pragma unroll
    for (int ct = 0; ct < 8; ++ct)
#pragma unroll
        for (int ks = 0; ks < 4; ++ks) { const bf16x8 bfr = *(const LAS bf16x8*)(Wt + (ct * 16 + fr) * 136 + ks * 32 + fq * 8); acc_i[ct] = __builtin_amdgcn_mfma_f32_16x16x32_bf16(bfr, af[ks], acc_i[ct], 0, 0, 0); }
    LDS_WAIT(); __syncthreads();
    {
        const int row = wave * 16 + fr;
#pragma unroll
        for (int ct = 0; ct < 8; ++ct) { const int c4 = ct * 16 + fq * 4;
            const pg8::f32x4 bav = *(const LAS pg8::f32x4*)(PAR + c4), biv = *(const LAS pg8::f32x4*)(PAR + 128 + c4), clv = *(const LAS pg8::f32x4*)(PAR + 256 + c4);
            const pg8::f32x4 xcv = *(const LAS pg8::f32x4*)(XC + row * 132 + c4); pg8::f32x4 av, bv;
#pragma unroll
            for (int j = 0; j < 4; ++j) { const float r = pg8::fast_sigmoid(acc_a[ct][j] + bav[j]), ig = pg8::fast_sigmoid(acc_i[ct][j] + biv[j]);
                const float la = clv[j] * r; const float a = __builtin_amdgcn_exp2f(1.44269504089f * la); av[j] = a;
                const float z = 2.0f * la; const float om = (z > -0.0625f) ? -z * (1.0f + z * (0.5f + z * (0.16666667f + z * 0.041666668f))) : (1.0f - a * a);
                bv[j] = __builtin_amdgcn_sqrtf(om) * (ig * xcv[j]); }
            *(LAS pg8::f32x4*)(AA + row * 132 + c4) = av; *(LAS pg8::f32x4*)(XC + row * 132 + c4) = bv; }
    }
    LDS_WAIT(); __syncthreads();
    if constexpr (!SAMPLE) {
        float hh = 0.f, pp = 1.f;
#pragma unroll 8
        for (int r = 0; r < 32; ++r) { const float a = AA[(rg * 32 + r) * 132 + ch], b = XC[(rg * 32 + r) * 132 + ch]; hh = a * hh + b; pp *= a; }
        SEG[tid * 2] = pp; SEG[tid * 2 + 1] = hh;
        LDS_WAIT(); __syncthreads();
        unsigned short gv[32];
        { const cgb GLp = (cgb)(ws + WS_GL) + (size_t)(row0 + rg * 32) * DLRU + ch0 + ch;
#pragma unroll
          for (int r = 0; r < 32; ++r) gv[r] = GLp[(size_t)r * DLRU]; }
        const int uidx = ((n * 8 + h) << 4) + cidx;
        GAS unsigned long long* cs = (GAS unsigned long long*)(ws + WS_CS) + ((size_t)l * 512 + uidx) * 128;
        gu32* flg = (gu32*)(ws + WS_CTL) + CW_LRUF + (l * 512 + ((n * 8 + h) << 4)) * 16;
        if (rg == 3) { float P = 1.f, Hh = 0.f;
#pragma unroll
            for (int sg = 0; sg < 4; ++sg) { const float ps = SEG[(sg * 128 + ch) * 2], hs = SEG[(sg * 128 + ch) * 2 + 1]; Hh = ps * Hh + hs; P *= ps; }
            __hip_atomic_store(cs + ch, ((unsigned long long)__float_as_uint(Hh) << 32) | (unsigned long long)__float_as_uint(P), RLX_AGENT); }
        VM_WAIT(); __syncthreads();
        if (tid == 0) __hip_atomic_store(flg + 16 * cidx, 1u, RLX_AGENT);
        if (cidx > 0) {
            if (wave == 0) { unsigned spins = 0;
                for (;;) { bool ok = true; if (lane < cidx) ok = __hip_atomic_load(flg + 16 * lane, RLX_AGENT) != 0u;
                    if (__all(ok)) break; __builtin_amdgcn_s_sleep(2); if (++spins > (1u << 20)) break; }
                __builtin_amdgcn_fence(__ATOMIC_ACQUIRE, "agent"); VM_WAIT(); }
            __syncthreads();
        }
        hh = 0.f;
        for (int j = 0; j < cidx; ++j) { const unsigned long long v = __hip_atomic_load(cs - (size_t)(cidx - j) * 128 + ch, RLX_AGENT); hh = __uint_as_float((unsigned)v) * hh + __uint_as_float((unsigned)(v >> 32)); }
        for (int sg = 0; sg < rg; ++sg) { const float ps = SEG[(sg * 128 + ch) * 2], hs = SEG[(sg * 128 + ch) * 2 + 1]; hh = ps * hh + hs; }
        {
            const gb Y = (gb)(ws + WS_YMIX) + (size_t)(row0 + rg * 32) * DM + ch0 + ch;
#pragma unroll
            for (int r = 0; r < 32; ++r) { const float a = AA[(rg * 32 + r) * 132 + ch], b = XC[(rg * 32 + r) * 132 + ch]; hh = a * hh + b; Y[(size_t)r * DM] = (bf16)f2bf(hh * bf2f(gv[r])); }
            if (cidx == 15 && rg == 3) out[OUT_HP + ((size_t)l * NB + n) * DLRU + ch0 + ch] = hh;
        }
    } else {
        const cgb GLp = (cgb)(ws + WS_GL); const gb YMIX = (gb)(ws + WS_YMIX);
#pragma unroll 2
        for (int e = 0; e < 8; ++e) { const int nb = blk * 32 + rg * 8 + e; float hh = TIN(6)[((size_t)l * DECB + nb) * DLRU + ch0 + ch];
#pragma unroll
            for (int t = 0; t < 4; ++t) { const int r = rg * 32 + e * 4 + t; const float a = AA[r * 132 + ch], b = XC[r * 132 + ch]; hh = a * hh + b;
                const size_t m = (size_t)(row0 + r); const float g = bf2f(GLp[m * DLRU + ch0 + ch]); YMIX[m * DM + ch0 + ch] = (bf16)f2bf(hh * g); }
            out[OUT_HS + ((size_t)l * DECB + nb) * DLRU + ch0 + ch] = hh; }
    }
    LDS_WAIT(); __syncthreads();
}

constexpr int SG_A = 0;
constexpr int SG_B = 34816;
constexpr int SG_ST = 69632;

__device__ __forceinline__ void sgu_unit(LAS unsigned char* lds, int l, int ui, int tid, int wave, int lane) {
    const int g = ui & 7, cidx = (ui >> 3) & 15, n = ui >> 7; const int row0 = n * SEQ + cidx * 128, col0 = g * 128;
    LAS bf16* At = (LAS bf16*)(lds + SG_A); LAS bf16* Bt = (LAS bf16*)(lds + SG_B); LAS float* ST = (LAS float*)(lds + SG_ST);
    const gu8 ws = TWS();
    v2u ur[8];
    { const cgb UGp = (cgb)(ws + WS_UG) + (size_t)(row0 + wave * 16 + (lane & 15)) * DSGU + col0 + (lane >> 4) * 4;
#pragma unroll
      for (int ct = 0; ct < 8; ++ct) ur[ct] = *(const GAS v2u*)(UGp + ct * 16); }
    if (tid < 128) { const GAS f32x4* p = (const GAS f32x4*)((cgf)(ws + WS_VST) + (size_t)(row0 + tid) * 32); float s = 0.f, q = 0.f;
#pragma unroll
        for (int j = 0; j < 8; ++j) { const f32x4 v = p[j]; s += v.x + v.z; q += v.y + v.w; }
        const float mean = s * (1.f / DSGU); const float var = fmaxf(q * (1.f / DSGU) - mean * mean, 0.f); ST[tid * 2] = mean; ST[tid * 2 + 1] = 1.0f / sqrtf(var + EPS); }
    {
        const GAS v4u* src = (const GAS v4u*)(ws + WS_W + (size_t)l * WL_SIZE + WL_SGW + (size_t)g * 32768);
#pragma unroll
        for (int j = 0; j < 4; ++j) { const int q = tid + 512 * j; *(LAS v4u*)(At + (q >> 4) * 136 + (q & 15) * 8) = src[q]; }
    }
    LDS_WAIT(); __syncthreads();
    {
        const int s = tid >> 2, dq = tid & 3; const float mean = ST[s * 2], rstd = ST[s * 2 + 1];
        const GAS f32x4* vp = (const GAS f32x4*)((cgf)(ws + WS_VG) + (size_t)(row0 + s) * DSGU + col0 + dq * 32);
        const GAS f32x4* gp = (const GAS f32x4*)(TIN(19) + ((size_t)l * 2 + 0) * DSGU + col0 + dq * 32); const GAS f32x4* bp = (const GAS f32x4*)(TIN(19) + ((size_t)l * 2 + 1) * DSGU + col0 + dq * 32);
#pragma unroll
        for (int jj = 0; jj < 8; ++jj) { const f32x4 v = vp[jj], gg = gp[jj], bb = bp[jj];
#pragma unroll
            for (int e = 0; e < 4; ++e) Bt[(dq * 32 + jj * 4 + e) * 136 + s] = (bf16)f2bf((v[e] - mean) * rstd * gg[e] + bb[e]); }
    }
    LDS_WAIT(); __syncthreads();
    const int fr = lane & 15, fq = lane >> 4;
    pg8::f32x4 acc[8];
#pragma unroll
    for (int ct = 0; ct < 8; ++ct) acc[ct] = (pg8::f32x4){0.f, 0.f, 0.f, 0.f};
    bf16x8 af[4];
#pragma unroll
    for (int ks = 0; ks < 4; ++ks) af[ks] = *(const LAS bf16x8*)(At + (wave * 16 + fr) * 136 + ks * 32 + fq * 8);
#pragma unroll
    for (int ct = 0; ct < 8; ++ct)
#pragma unroll
        for (int ks = 0; ks < 4; ++ks) { const bf16x8 bfr = *(const LAS bf16x8*)(Bt + (ct * 16 + fr) * 136 + ks * 32 + fq * 8); acc[ct] = __builtin_amdgcn_mfma_f32_16x16x32_bf16(bfr, af[ks], acc[ct], 0, 0, 0); }
    {
        const int t = wave * 16 + fr; const float bias = TIN(21)[((size_t)l * 8 + g) * CHUNK + t]; const size_t m = (size_t)(row0 + t);
        const gb YMIX = (gb)(ws + WS_YMIX);
#pragma unroll
        for (int ct = 0; ct < 8; ++ct) { const int d = ct * 16 + fq * 4; const v2u uw = ur[ct];
            v2u o; o.x = pg8::cvt_pk_bf16(bflo(uw.x) * (acc[ct][0] + bias), bfhi(uw.x) * (acc[ct][1] + bias)); o.y = pg8::cvt_pk_bf16(bflo(uw.y) * (acc[ct][2] + bias), bfhi(uw.y) * (acc[ct][3] + bias));
            *(GAS v2u*)(YMIX + m * DM + DLRU + col0 + d) = o; }
    }
    LDS_WAIT(); __syncthreads();
}
__device__ __forceinline__ void sgu_sample_item(LAS unsigned char* lds, int l, int nb, int lane) {
    float vn[4][16];
    const int cbase = lane * 16;
    const gu8 ws = TWS(); const gf out = TOUT();
    const cgf lng = TIN(19) + ((size_t)l * 2 + 0) * DSGU + cbase; const cgf lnb = TIN(19) + ((size_t)l * 2 + 1) * DSGU + cbase;
#pragma unroll
    for (int t = 0; t < 4; ++t) { const size_t m = (size_t)(MP + nb * 4 + t);
        const GAS f32x4* vp = (const GAS f32x4*)((cgf)(ws + WS_VG) + m * DSGU + cbase); const GAS f32x4* gp = (const GAS f32x4*)lng; const GAS f32x4* bp = (const GAS f32x4*)lnb;
        f32x4 v[4]; float sm = 0.f;
#pragma unroll
        for (int j = 0; j < 4; ++j) { v[j] = vp[j]; sm += (v[j].x + v[j].y) + (v[j].z + v[j].w); }
        const float mean = wave_sum(sm) * (1.f / DSGU); float sq = 0.f;
#pragma unroll
        for (int j = 0; j < 4; ++j)
#pragma unroll
            for (int e = 0; e < 4; ++e) { const float d = v[j][e] - mean; sq += d * d; }
        const float rstd = 1.0f / sqrtf(wave_sum(sq) * (1.f / DSGU) + EPS);
        GAS f32x4* op = (GAS f32x4*)(out + OUT_VS + (((size_t)l * DECB + nb) * 4 + t) * DSGU + cbase);
#pragma unroll
        for (int j = 0; j < 4; ++j) { const f32x4 gg = gp[j], bb = bp[j]; f32x4 o;
#pragma unroll
            for (int e = 0; e < 4; ++e) { o[e] = (v[j][e] - mean) * rstd * gg[e] + bb[e]; vn[t][j * 4 + e] = o[e]; }
            op[j] = o; } }
    const int g = cbase >> 7;
    const cgf sgw = TIN(20) + ((size_t)l * 8 + g) * 16384; const cgf sgb = TIN(21) + ((size_t)l * 8 + g) * CHUNK;
#pragma unroll
    for (int t = 0; t < 4; ++t) { const size_t m = (size_t)(MP + nb * 4 + t); const float bias = sgb[t];
        float w[4];
#pragma unroll
        for (int s = 0; s < 4; ++s) w[s] = (s <= t) ? sgw[t * 128 + s] : 0.f;
        const GAS v4u* up = (const GAS v4u*)((cgb)(ws + WS_UG) + m * DSGU + cbase); GAS v4u* yp = (GAS v4u*)((gb)(ws + WS_YMIX) + m * DM + DLRU + cbase);
#pragma unroll
        for (int j = 0; j < 2; ++j) { const v4u uw = up[j]; float sv[8];
#pragma unroll
            for (int e = 0; e < 8; ++e) { float acc = bias;
#pragma unroll
                for (int s = 0; s < 4; ++s) acc += w[s] * vn[s][j * 8 + e];
                sv[e] = acc; }
            v4u o; o.x = pk2(bflo(uw.x) * sv[0], bfhi(uw.x) * sv[1]); o.y = pk2(bflo(uw.y) * sv[2], bfhi(uw.y) * sv[3]); o.z = pk2(bflo(uw.z) * sv[4], bfhi(uw.z) * sv[5]); o.w = pk2(bflo(uw.w) * sv[6], bfhi(uw.w) * sv[7]);
            yp[j] = o; } }
}

__device__ __forceinline__ void lru_fix_unit(LAS unsigned char* lds, int l, int ui, int wave, int lane) {
    const int qd = ui & 3, cidx = (ui >> 2) & 15, n = ui >> 6; const int cch = qd * 256 + lane * 4;
    const gu8 ws = TWS();
    const cgf HLOC = (cgf)(ws + WS_HLOC), PC = (cgf)(ws + WS_PC), CSUM = (cgf)(ws + WS_CSUM); const cgb GLp = (cgb)(ws + WS_GL); const gb YMIX = (gb)(ws + WS_YMIX);
    f32x4 H = (f32x4){0.f, 0.f, 0.f, 0.f};
    for (int j = 0; j < cidx; ++j) { const GAS f32x4* cs = (const GAS f32x4*)(CSUM + ((size_t)(n * 16 + j) * DLRU + cch) * 2); const f32x4 c0 = cs[0], c1 = cs[1];
        H.x = c0.x * H.x + c0.y; H.y = c0.z * H.y + c0.w; H.z = c1.x * H.z + c1.y; H.w = c1.z * H.w + c1.w; }
#pragma unroll 4
    for (int r = 0; r < 16; ++r) { const int t = cidx * 128 + wave * 16 + r; const size_t m = (size_t)(n * SEQ + t);
        const f32x4 hl = *(const GAS f32x4*)(HLOC + m * DLRU + cch), pc = *(const GAS f32x4*)(PC + m * DLRU + cch); const v2u gw = *(const GAS v2u*)(GLp + m * DLRU + cch);
        const f32x4 hv = hl + pc * H;
        v2u o; o.x = pk2(hv.x * bflo(gw.x), hv.y * bfhi(gw.x)); o.y = pk2(hv.z * bflo(gw.y), hv.w * bfhi(gw.y));
        *(GAS v2u*)(YMIX + m * DM + cch) = o;
        if (t == SEQ - 1) *(GAS f32x4*)(TOUT() + OUT_HP + ((size_t)l * NB + n) * DLRU + cch) = hv; }
}

constexpr int SA_SC = 0;
constexpr int SA_O = 4096;
__device__ __forceinline__ void sattn_unit(LAS unsigned char* lds, int l, int ui, int tid, int wave, int lane) {
    const int h = ui & 3, nb = ui >> 2;
    LAS float* SC = (LAS float*)(lds + SA_SC); LAS float* OA = (LAS float*)(lds + SA_O);
    const gu8 ws = TWS();
    const cgf kbase = TIN(3) + (((size_t)l * DECB + nb) * MEML * XAH + h) * XAD + lane * 8;
    {
        float q[4][8];
#pragma unroll
        for (int t = 0; t < 4; ++t) { const v4u w = *(const GAS v4u*)((cgb)(ws + WS_QB) + (size_t)(MP + nb * 4 + t) * DM + h * XAD + lane * 8);
            q[t][0] = bflo(w.x); q[t][1] = bfhi(w.x); q[t][2] = bflo(w.y); q[t][3] = bfhi(w.y); q[t][4] = bflo(w.z); q[t][5] = bfhi(w.z); q[t][6] = bflo(w.w); q[t][7] = bfhi(w.w); }
#pragma unroll 1
        for (int kb = 0; kb < 4; ++kb) {
            const int key0 = wave * 32 + kb * 8;
            f32x4 kv[8][2];
#pragma unroll
            for (int j = 0; j < 8; ++j) { const GAS f32x4* kp = (const GAS f32x4*)(kbase + (size_t)(key0 + j) * (XAH * XAD)); kv[j][0] = kp[0]; kv[j][1] = kp[1]; }
            float v[32];
#pragma unroll
            for (int j = 0; j < 8; ++j)
#pragma unroll
                for (int t = 0; t < 4; ++t) { v[j * 4 + t] = (q[t][0] * kv[j][0].x + q[t][1] * kv[j][0].y) + (q[t][2] * kv[j][0].z + q[t][3] * kv[j][0].w) + (q[t][4] * kv[j][1].x + q[t][5] * kv[j][1].y) + (q[t][6] * kv[j][1].z + q[t][7] * kv[j][1].w); }
#pragma unroll
            for (int j = 0; j < 32; ++j) v[j] += pg8::shx(v[j], 32);
#pragma unroll
            for (int s = 0; s < 5; ++s) { const int off = 16 >> s; const bool up = (lane & off) != 0;
#pragma unroll
                for (int j = 0; j < (16 >> s); ++j) { const float keep = up ? v[j + off] : v[j]; const float send = up ? v[j] : v[j + off]; v[j] = keep + pg8::shx(send, off); } }
            if (lane < 32) SC[(lane & 3) * 256 + key0 + (lane >> 2)] = v[0];
        }
    }
    LDS_WAIT(); __syncthreads();
    if (wave < 4) { const float sl2 = 0.04419417382f * 1.44269504089f; f32x4 s = *(const LAS f32x4*)(SC + wave * 256 + lane * 4);
        const float mx = wave_max(fmaxf(fmaxf(s.x, s.y), fmaxf(s.z, s.w))) * sl2;
        s.x = __builtin_amdgcn_exp2f(s.x * sl2 - mx); s.y = __builtin_amdgcn_exp2f(s.y * sl2 - mx); s.z = __builtin_amdgcn_exp2f(s.z * sl2 - mx); s.w = __builtin_amdgcn_exp2f(s.w * sl2 - mx);
        const float inv = 1.0f / wave_sum((s.x + s.y) + (s.z + s.w));
        *(LAS f32x4*)(SC + wave * 256 + lane * 4) = s * inv; }
    LDS_WAIT(); __syncthreads();
    {
        const cgf vbase = TIN(4) + (((size_t)l * DECB + nb) * MEML * XAH + h) * XAD + lane * 8;
        float o[4][8];
#pragma unroll
        for (int t = 0; t < 4; ++t)
#pragma unroll
            for (int e = 0; e < 8; ++e) o[t][e] = 0.f;
#pragma unroll 1
        for (int kb = 0; kb < 4; ++kb) {
            const int key0 = wave * 32 + kb * 8;
            f32x4 vv[8][2];
#pragma unroll
            for (int j = 0; j < 8; ++j) { const GAS f32x4* vp = (const GAS f32x4*)(vbase + (size_t)(key0 + j) * (XAH * XAD)); vv[j][0] = vp[0]; vv[j][1] = vp[1]; }
#pragma unroll
            for (int j = 0; j < 8; ++j)
#pragma unroll
                for (int t = 0; t < 4; ++t) { const float p = SC[t * 256 + key0 + j];
                    o[t][0] += p * vv[j][0].x; o[t][1] += p * vv[j][0].y; o[t][2] += p * vv[j][0].z; o[t][3] += p * vv[j][0].w; o[t][4] += p * vv[j][1].x; o[t][5] += p * vv[j][1].y; o[t][6] += p * vv[j][1].z; o[t][7] += p * vv[j][1].w; }
        }
#pragma unroll
        for (int t = 0; t < 4; ++t) { *(LAS f32x4*)(OA + (wave * 4 + t) * 512 + lane * 8) = (f32x4){o[t][0], o[t][1], o[t][2], o[t][3]}; *(LAS f32x4*)(OA + (wave * 4 + t) * 512 + lane * 8 + 4) = (f32x4){o[t][4], o[t][5], o[t][6], o[t][7]}; }
    }
    LDS_WAIT(); __syncthreads();
    {
        const int t = tid >> 7, d = (tid & 127) * 4; f32x4 s = (f32x4){0.f, 0.f, 0.f, 0.f};
#pragma unroll
        for (int w = 0; w < 8; ++w) s = s + *(const LAS f32x4*)(OA + (w * 4 + t) * 512 + d);
        v2u ov; ov.x = pk2(s.x, s.y); ov.y = pk2(s.z, s.w);
        *(GAS v2u*)((gb)(ws + WS_OB) + (size_t)(MP + nb * 4 + t) * DM + h * XAD + d) = ov;
    }
    LDS_WAIT(); __syncthreads();
}

constexpr int NPHASES = 1 + 16 * DEPTH;

__global__ void __launch_bounds__(NWAVES * 64, 2) fwd(Args args) {
    extern __shared__ __attribute__((aligned(16))) unsigned char lds_raw[];
    LAS unsigned char* lds = (LAS unsigned char*)lds_raw;
    volatile LAS unsigned* MISC = (volatile LAS unsigned*)(lds + MISC_OFF);
    const int G = gridDim.x, bx = blockIdx.x;
    const int wave_s = __builtin_amdgcn_readfirstlane((int)(threadIdx.x >> 6));
#define PHASE_IDS() int tid = wave_s * 64 + pg8::lane_id(); asm volatile("" : "+v"(tid)); const int lane = tid & 63, wave = __builtin_amdgcn_readfirstlane(tid >> 6); \
    const int vcu = (G % 8 == 0) ? (bx % 8) * (G / 8) + bx / 8 : bx; const int gw = vcu * NWAVES + wave, NGW = G * NWAVES; (void)lane; (void)gw; (void)NGW
    for (int u = threadIdx.x; u < 64; u += NWAVES * 64) ((LAS unsigned*)(lds + MISC_OFF))[u] = 0u;
    if (threadIdx.x == 0) { LAS unsigned long long* TAB = (LAS unsigned long long*)(lds + TAB_OFF);
#pragma unroll
        for (int i = 0; i < 30; ++i) TAB[i] = (unsigned long long)args.in[i];
        TAB[30] = (unsigned long long)args.out; TAB[31] = (unsigned long long)args.ws; }
    __syncthreads();
#if !MK_PER_PHASE
    (void)xcd_barrier_post((GAS unsigned*)(args.ws + WS_CTL) + CW_BAR, MISC + 8, threadIdx.x == 0);
#define GRID_BAR() do { XcdBarrier b_; const unsigned long long bp_ = tab_ld(lds, 31) + WS_CTL + 4ull * CW_BAR; unsigned blo_ = (unsigned)bp_, bhi_ = (unsigned)(bp_ >> 32); unsigned x_ = __builtin_amdgcn_readfirstlane(xb_xcc_id()), st_ = __builtin_amdgcn_readfirstlane((unsigned)(size_t)(LAS unsigned*)(lds + MISC_OFF + 32)); asm volatile("" : "+s"(blo_), "+s"(bhi_), "+s"(x_), "+s"(st_)); b_.bar = (GAS unsigned*)(((unsigned long long)bhi_ << 32) | blo_); b_.x = x_; b_.st = (volatile LAS unsigned*)(size_t)st_; xcd_barrier(b_, wave_s == 0 && pg8::lane_id() == 0); } while (0)
#else
#define GRID_BAR() do {} while (0)
#endif
    const int lo = args.ph_lo, hi = args.ph_hi;
#define IN(k) (lo <= (k) && (k) < hi)
#define SEAM(k) do { if (IN(k) && IN((k) + 1)) GRID_BAR(); } while (0)

    if (PHT(16) && IN(0)) { PHASE_IDS();
        const gu8 ws = TWS();
        LAS float* scr = (LAS float*)(lds + wave * 16384);
        constexpr int I_FIN = (DM / 64) * (2 * DFF / 32), I_FDN = (DFF / 64) * (DM / 32), I_WIN = (DM / 64) * (4096 / 32), I_SQ = (DM / 64) * (DM / 32), I_LR = 8 * 2 * 4;
        constexpr int I_LAYER = 2 * I_FIN + 2 * I_FDN + 2 * I_WIN + 3 * I_SQ + 2 * I_LR;
        for (int it = gw; it < DEPTH * I_LAYER; it += NGW) {
            const int l = it / I_LAYER; int r = it - l * I_LAYER;
            const gu8 wl = ws + WS_W + (size_t)l * WL_SIZE;
            if (r < I_FIN) { p0_mat_ffn_in(TIN(8) + (size_t)l * DM * 2 * DFF, (gb)(wl + WL_FIN1), r, scr, lane, TIN(7) + ((size_t)l * 2 + 0) * DM); continue; } r -= I_FIN;
            if (r < I_FIN) { p0_mat_ffn_in(TIN(28) + (size_t)l * DM * 2 * DFF, (gb)(wl + WL_FIN2), r, scr, lane, TIN(27) + ((size_t)l * 2 + 0) * DM); continue; } r -= I_FIN;
            if (r < I_FDN) { p0_mat(TIN(9) + (size_t)l * DFF * DM, DFF, DM, (gb)(wl + WL_FDN1), r, scr, lane); continue; } r -= I_FDN;
            if (r < I_FDN) { p0_mat(TIN(29) + (size_t)l * DFF * DM, DFF, DM, (gb)(wl + WL_FDN2), r, scr, lane); continue; } r -= I_FDN;
            if (r < I_WIN) { p0_mat(TIN(11) + (size_t)l * DM * 4096, DM, 4096, (gb)(wl + WL_WIN), r, scr, lane, TIN(10) + ((size_t)l * 2 + 0) * DM); continue; } r -= I_WIN;
            if (r < I_WIN) { p0_mat(TIN(25) + (size_t)l * DM * 4096, DM, 4096, (gb)(wl + WL_WKV), r, scr, lane); continue; } r -= I_WIN;
            if (r < I_SQ) { p0_mat(TIN(22) + (size_t)l * DM * DM, DM, DM, (gb)(wl + WL_WOUT), r, scr, lane); continue; } r -= I_SQ;
            if (r < I_SQ) { p0_mat(TIN(24) + (size_t)l * DM * DM, DM, DM, (gb)(wl + WL_WQ), r, scr, lane, TIN(23) + ((size_t)l * 3 + 0) * DM); continue; } r -= I_SQ;
            if (r < I_SQ) { p0_mat(TIN(26) + (size_t)l * DM * DM, DM, DM, (gb)(wl + WL_WO), r, scr, lane); continue; } r -= I_SQ;
            if (r < I_LR) { const int hh = r >> 3; p0_mat(TIN(14) + ((size_t)l * 8 + hh) * 16384, 128, 128, (gb)(wl + WL_LRA) + (size_t)hh * 16384, r & 7, scr, lane); continue; } r -= I_LR;
            { const int hh = r >> 3; p0_mat(TIN(16) + ((size_t)l * 8 + hh) * 16384, 128, 128, (gb)(wl + WL_LRI) + (size_t)hh * 16384, r & 7, scr, lane); }
        }
        const int R1_ = (DEPTH * I_LAYER) % NGW, R2_ = (R1_ + DEPTH * MMEM) % NGW, R3_ = (R2_ + MT) % NGW;
#define P0_ROT(R) ((gw >= (R)) ? gw - (R) : gw + NGW - (R))
        { const cgf sgw = TIN(20);
        for (int i = P0_ROT(R3_) * 64 + lane; i < DEPTH * 8 * 128 * 128 / 4; i += NGW * 64) { const int e = i * 4; const int l = e >> 17, rem = e & 131071, t = (rem >> 7) & 127, s0 = rem & 127;
            const f32x4 w = *(const GAS f32x4*)(sgw + e);
            v2u o; o.x = pk2(s0 <= t ? w.x : 0.f, s0 + 1 <= t ? w.y : 0.f); o.y = pk2(s0 + 2 <= t ? w.z : 0.f, s0 + 3 <= t ? w.w : 0.f);
            *(GAS v2u*)((gb)(ws + WS_W + (size_t)l * WL_SIZE + WL_SGW) + rem) = o; } }
        { const cgf mem = TIN(2); const cgf xan = TIN(23);
        for (int m = P0_ROT(R1_); m < DEPTH * MMEM; m += NGW) { const int l = m / MMEM, r = m % MMEM; rms_row_to_bf16(mem + (size_t)r * DM, xan + ((size_t)l * 3 + 2) * DM, (gb)(ws + WS_MEMN) + (size_t)m * DM, lane); } }
        { const cgf xp = TIN(0); const cgf xs = TIN(1);
        for (int m = P0_ROT(R2_); m < MT; m += NGW) { const cgf xr = (m < MP) ? xp + (size_t)m * DM : xs + (size_t)(m - MP) * DM; x_row_init(xr, (gb)(ws + WS_HB) + (size_t)m * DM, (gf)(ws + WS_RS) + (size_t)m * 8, lane); } }
    }
#undef P0_ROT
    SEAM(0);

    for (int l = 0; l < DEPTH; ++l) {
        const int pb = 1 + 16 * l;
#define FFN_IN_PHASE(ph, WOFF, WITHKV) if (PHT(0) && IN(ph)) { const gu8 ws = TWS(); const gf out = TOUT(); \
            SchedFfnIn S{(cgc)(ws + WS_HB), (cgc)(ws + WS_W + (size_t)l * WL_SIZE + (WOFF)), (cgc)(ws + WS_MEMN + (size_t)l * MMEM * DM * 2), (cgc)(ws + WS_W + (size_t)l * WL_SIZE + WL_WKV), G, bx, (WITHKV)}; \
            pg8::EpiFfnIn E{(gb)(ws + WS_ACT), DFF, out + OUT_MK + (size_t)l * MMEM * DM, (gb)(ws + WS_KB), out + OUT_MV + (size_t)l * MMEM * DM, (gb)(ws + WS_VT), (cgf)(ws + WS_RS)}; \
            pg8::gemm_phase<pg8::EpiFfnIn, SchedFfnIn, true, true, false, true>(lds, wave_s, DM, DM, S, E); } SEAM(ph);
#define TG_PHASE(ph, PHT_ID, AOFF, WOFF, KK, KINST, G1, CC) if (PHT(PHT_ID) && IN(ph)) { const gu8 ws = TWS(); const int inst = l * 4 + (KINST); \
            SchedStrip<false> S{(cgc)(ws + (AOFF)), (cgc)(ws + WS_W + (size_t)l * WL_SIZE + (WOFF)), (KK), (KK), DM / 256, (KK), G, bx}; \
            pg8::EpiT E{TIN(0), TIN(1), (gb)(ws + WS_HB), TOUT(), (G1), (CC), (gf)(ws + WS_TXB) + (size_t)inst * 32 * 272 * 8, (GAS unsigned*)(ws + WS_CTL) + CW_TC + inst * 512, (gf)(ws + WS_RS), \
                        (inst == 0) ? 1 : ((inst == 4 * DEPTH - 1) ? 2 : 0)}; \
            pg8::gemm_phase<pg8::EpiT, SchedStrip<false>, false, true, true, KOUT_T>(lds, wave_s, (KK), (KK), S, E); } SEAM(ph);
        FFN_IN_PHASE(pb + 0, WL_FIN1, 1)
        TG_PHASE(pb + 1, 1, WS_ACT, WL_FDN1, DFF, 0, TIN(7) + ((size_t)l * 2 + 1) * DM, 0.5f)

        if (PHT(3) && IN(pb + 3)) { const gu8 ws = TWS();
            SchedStrip<true> S{(cgc)(ws + WS_HB), (cgc)(ws + WS_W + (size_t)l * WL_SIZE + WL_WIN), DM, DM, 16, DM, G, bx};
            pg8::EpiMixIn E{(gf)(ws + WS_XL), (gb)(ws + WS_GL), (gb)(ws + WS_UG), (gf)(ws + WS_VG), (gf)(ws + WS_VST), (gf)(ws + WS_SLAB), (cgf)(ws + WS_RS)};
            pg8::gemm_phase<pg8::EpiMixIn, SchedStrip<true>, true, true, true, KOUT_M>(lds, wave_s, DM, DM, S, E);
        }
        SEAM(pb + 3);

        if (PHT(4) && IN(pb + 4)) { PHASE_IDS();
            constexpr int NU_LP = NB * 16 * 8, NU_LS = (MS / 128) * 8, NU_SS = DECB / NWAVES, NU_SG = NB * 16 * 8; static_assert(DECB % NWAVES == 0, "sample SGU items per queue item");
            for (int u = bx; u < NU_LP; u += G) lru_unit<false>(lds, l, u, tid, wave, lane);
            {
                gu32* qc = (gu32*)(TWS() + WS_CTL) + CW_QC + l * 64;
                for (;;) {
                    if (tid == 0) MISC[16] = __hip_atomic_fetch_add(qc, 1u, RLX_AGENT);
                    __syncthreads(); const int it = __builtin_amdgcn_readfirstlane((int)MISC[16]); __syncthreads();
                    if (it >= NU_LS + NU_SS + NU_SG) break;
                    if (it < NU_LS) lru_unit<true>(lds, l, it, tid, wave, lane);
                    else if (it < NU_LS + NU_SS) sgu_sample_item(lds, l, (it - NU_LS) * NWAVES + wave, lane);
                    else sgu_unit(lds, l, it - NU_LS - NU_SS, tid, wave, lane);
                }
            }
        }
        SEAM(pb + 4);

        TG_PHASE(pb + 6, 6, WS_YMIX, WL_WOUT, DM, 1, TIN(10) + ((size_t)l * 2 + 1) * DM, 1.0f)

        if (PHT(8) && IN(pb + 8)) { const gu8 ws = TWS();
            SchedStrip<false> S{(cgc)(ws + WS_HB), (cgc)(ws + WS_W + (size_t)l * WL_SIZE + WL_WQ), DM, DM, DM / 256, DM, G, bx};
            pg8::EpiQ E{(gb)(ws + WS_QB), (gf)(ws + WS_SLAB), (cgf)(ws + WS_RS), MP};
            pg8::gemm_phase<pg8::EpiQ, SchedStrip<false>, true, true, true, KOUT_Q>(lds, wave_s, DM, DM, S, E);
        }
        SEAM(pb + 8);

        const bool fuse_pv = (G >= NB * XAH * 8 * 2);
        if (PHT(9) && IN(pb + 9)) {
            gu32* xf = (gu32*)(TWS() + WS_CTL) + CW_XF + l * (NB * XAH * 8) * 16;
            { const gu8 ws = TWS();
            SchedX1 S{(cgc)(ws + WS_QB), (cgc)(ws + WS_KB), G, bx};
            pg8::EpiSoftmax E{(gb)(ws + WS_PB), 1024, 0.04419417382f * 1.44269504089f};
            pg8::gemm_phase<pg8::EpiSoftmax, SchedX1, false, true>(lds, wave_s, DM, DM, S, E); }
            VM_WAIT(); __syncthreads(); PHASE_IDS();
            if (fuse_pv && bx < NB * XAH * 8 && tid == 0) {
                __builtin_amdgcn_fence(__ATOMIC_RELEASE, "agent"); VM_WAIT();
                __hip_atomic_store(xf + 16 * bx, 1u, RLX_AGENT); }
            for (int u = bx; u < DECB * XAH; u += G) sattn_unit(lds, l, u, tid, wave, lane);
            if (fuse_pv && bx >= NB * XAH * 8 && bx < NB * XAH * 8 * 2) {
                const int cc = bx - NB * XAH * 8;
                if (wave == 0) { unsigned spins = 0;
                    while ((unsigned)__builtin_amdgcn_readfirstlane((int)__hip_atomic_load(xf + 16 * cc, RLX_AGENT)) == 0u) { __builtin_amdgcn_s_sleep(1); if (++spins > (1u << 20)) break; }
                    __builtin_amdgcn_fence(__ATOMIC_ACQUIRE, "agent"); VM_WAIT(); }
                __syncthreads();
                const gu8 ws = TWS();
                SchedX2pair S{(cgc)(ws + WS_PB), (cgc)(ws + WS_VT), cc};
                pg8::EpiBf16 E{(gb)(ws + WS_OB), DM};
                pg8::gemm_phase<pg8::EpiBf16, SchedX2pair, true, true>(lds, wave_s, 1024, 1024, S, E);
            }
        }
        SEAM(pb + 9);

        if (!fuse_pv) {
        if (PHT(10) && IN(pb + 10)) { const gu8 ws = TWS();
            SchedX2 S{(cgc)(ws + WS_PB), (cgc)(ws + WS_VT), G, bx};
            pg8::EpiBf16 E{(gb)(ws + WS_OB), DM};
            pg8::gemm_phase<pg8::EpiBf16, SchedX2, true, true>(lds, wave_s, 1024, 1024, S, E);
        }
        SEAM(pb + 10);
        }

        TG_PHASE(pb + 11, 6, WS_OB, WL_WO, DM, 2, TIN(23) + ((size_t)l * 3 + 1) * DM, 1.0f)
        FFN_IN_PHASE(pb + 13, WL_FIN2, 0)
        TG_PHASE(pb + 14, 1, WS_ACT, WL_FDN2, DFF, 3, TIN(27) + ((size_t)l * 2 + 1) * DM, 0.5f)
    }
#undef IN
#undef SEAM
}

extern "C" void kernel_launch(void* const* d_in, const int* in_sizes, int n_in, void* d_out, int out_size, void* d_ws, size_t ws_size, hipStream_t stream) {
    static int grid = 0;
    if (grid == 0) {
        if (n_in != 30 || (size_t)out_size != OUT_END || ws_size < WS_END) { fprintf(stderr, "kernel_launch: built for 30 inputs, %zu outputs, >= %zu bytes of workspace; got n_in %d, out %d, ws %zu; nothing launched\n", (size_t)OUT_END, (size_t)WS_END, n_in, out_size, ws_size); grid = -1; return; }
        int dev = 0, cus = 0, per_cu = 0;
        if (hipGetDevice(&dev) != hipSuccess || hipDeviceGetAttribute(&cus, hipDeviceAttributeMultiprocessorCount, dev) != hipSuccess) { fprintf(stderr, "kernel_launch: device query failed\n"); grid = -1; return; }
        if (hipFuncSetAttribute((const void*)fwd, hipFuncAttributeMaxDynamicSharedMemorySize, LDS_BYTES) != hipSuccess) { fprintf(stderr, "kernel_launch: hipFuncSetAttribute failed\n"); grid = -1; return; }
        if (hipOccupancyMaxActiveBlocksPerMultiprocessor(&per_cu, (const void*)fwd, NWAVES * 64, LDS_BYTES) != hipSuccess || per_cu < 1) { fprintf(stderr, "kernel_launch: occupancy query reports %d\n", per_cu); }
        (void)hipGetLastError();
        grid = cus;
    }
    if (grid < 0) return;
    if (hipMemsetAsync((char*)d_ws + WS_CTL, 0, CTL_ZERO_BYTES, stream) != hipSuccess) { fprintf(stderr, "kernel_launch: memset failed\n"); return; }
    Args a{};
    for (int i = 0; i < 30; ++i) a.in[i] = (const float*)d_in[i];
    a.out = (float*)d_out; a.ws = (unsigned char*)d_ws;
#if MK_PER_PHASE
    for (int p = 0; p < NPHASES; ++p) { a.ph_lo = p; a.ph_hi = p + 1; hipLaunchKernelGGL(fwd, dim3(grid), dim3(NWAVES * 64), LDS_BYTES, stream, a); }
#else
    a.ph_lo = 0; a.ph_hi = NPHASES - 1;
    hipLaunchKernelGGL(fwd, dim3(grid), dim3(NWAVES * 64), LDS_BYTES, stream, a);
#endif
    const hipError_t le = hipPeekAtLastError();
    if (le != hipSuccess) fprintf(stderr, "kernel_launch: launch failed: %s\n", hipGetErrorName(le));
}
```
